# Optimizing an MI355X kernel written in HIP

```python
import jax, jax.numpy as jnp
from jax import lax
import numpy as np

D_MODEL = 1024
BATCH = 8
SEQ = 8192
DEPTH = 4

HEAD_DIM = 64
SB_WIDTH = D_MODEL // 2
SB_HEADS = SB_WIDTH // HEAD_DIM
Q_BLOCK = 128
SB_WINDOW = 512
KV_SPAN = SB_WINDOW + Q_BLOCK
POOL_WIDTH = D_MODEL // 4
POOL_WINDOWS = (2, 4, 8, 16)
POOL_GROUPS = len(POOL_WINDOWS)
POOL_GROUP_DIM = POOL_WIDTH // POOL_GROUPS
SG_WIDTH = D_MODEL // 4
SG_HEADS = 4
SG_HEAD_DIM = SG_WIDTH // SG_HEADS
CHUNK = 128
MIX_WIDTH = SB_WIDTH + POOL_WIDTH + SG_WIDTH
IN_WIDTH = 3 * SB_WIDTH + POOL_WIDTH + 2 * SG_WIDTH
SPLITS = tuple(int(i) for i in np.cumsum([SB_WIDTH, SB_WIDTH, SB_WIDTH, POOL_WIDTH, SG_WIDTH]))
D_FF = -(-8 * D_MODEL // (3 * 256)) * 256
N_MOD = 6
EPS = 1e-6

kernel_name = 'hybrid_sb_pool_sgmlp_adaln_trunk'


def rmsnorm(x, g):
    xf = x.astype(jnp.float32)
    y = xf * lax.rsqrt(jnp.mean(xf * xf, axis=-1, keepdims=True) + EPS)
    return (y * g.astype(jnp.float32)).astype(x.dtype)


def layernorm(x, g):
    xf = x.astype(jnp.float32)
    mu = jnp.mean(xf, axis=-1, keepdims=True)
    var = jnp.mean(jnp.square(xf - mu), axis=-1, keepdims=True)
    return ((xf - mu) * lax.rsqrt(var + EPS) * g.astype(jnp.float32)).astype(x.dtype)


def stick_breaking_attention(q, k, v):
    b, s, h, d = q.shape
    nb = s // Q_BLOCK
    qb = q.reshape(b, nb, Q_BLOCK, h, d).transpose(1, 0, 2, 3, 4)
    pad = ((0, 0), (SB_WINDOW, 0), (0, 0), (0, 0))
    kp = jnp.pad(k.astype(jnp.float32), pad)
    vp = jnp.pad(v.astype(jnp.float32), pad)
    scale = d ** -0.5

    def one_block(args):
        q_blk, i = args
        start = i * Q_BLOCK
        k_blk = lax.dynamic_slice_in_dim(kp, start, KV_SPAN, axis=1)
        v_blk = lax.dynamic_slice_in_dim(vp, start, KV_SPAN, axis=1)
        q_pos = i * Q_BLOCK + jnp.arange(Q_BLOCK)
        key_pos = i * Q_BLOCK - SB_WINDOW + jnp.arange(KV_SPAN)
        valid = ((key_pos[None, :] < q_pos[:, None])
                 & (key_pos[None, :] >= q_pos[:, None] - SB_WINDOW)
                 & (key_pos[None, :] >= 0))
        z = jnp.einsum('bqhd,bkhd->bhqk', q_blk.astype(jnp.float32), k_blk) * scale
        log_rest = jnp.where(valid, jax.nn.log_sigmoid(-z), 0.0)
        later = lax.cumsum(log_rest, axis=3, reverse=True) - log_rest
        w = jnp.where(valid, jnp.exp(log_rest + z + later), 0.0)
        return jnp.einsum('bhqk,bkhd->bqhd', w, v_blk)

    out = lax.map(one_block, (qb, jnp.arange(nb)))
    return out.transpose(1, 0, 2, 3, 4).reshape(b, s, h * d).astype(q.dtype)


def multiscale_pool(p, w_pool, pool_scale):
    b, s, _ = p.shape
    pg = p.astype(jnp.float32).reshape(b, s, POOL_GROUPS, POOL_GROUP_DIM)
    maxw = max(POOL_WINDOWS)
    csp = jnp.pad(jnp.cumsum(pg, axis=1), ((0, 0), (maxw, 0), (0, 0), (0, 0)))
    pos = jnp.arange(s)
    outs = []
    for g, w in enumerate(POOL_WINDOWS):
        window_sum = csp[:, maxw:, g] - csp[:, maxw - w:maxw - w + s, g]
        count = jnp.minimum(pos + 1, w).astype(jnp.float32)[None, :, None]
        outs.append(window_sum / count - pg[:, :, g])
    pooled = jnp.stack(outs, axis=2)
    mixed = jnp.einsum('bsgc,gce->bsge', pooled, w_pool.astype(jnp.float32))
    return (mixed.reshape(b, s, POOL_WIDTH) * pool_scale).astype(p.dtype)


def chunked_spatial_gating(u, vg, sg_norm, w_s, b_s):
    b, s, _ = u.shape
    n = s // CHUNK
    u = jax.nn.gelu(u)
    vn = layernorm(jax.nn.gelu(vg), sg_norm)
    vh = vn.reshape(b, n, CHUNK, SG_HEADS, SG_HEAD_DIM)
    causal = jnp.tril(jnp.ones((CHUNK, CHUNK), dtype=bool))
    ws = jnp.where(causal[None], w_s, 0.0)
    mixed = jnp.einsum('hts,bnshd->bnthd', ws, vh) + b_s.T[None, None, :, :, None]
    return u * mixed.reshape(b, s, SG_WIDTH)


def setup_inputs(seed: int = 0) -> dict:
    key = jax.random.key(seed)
    ks = jax.random.split(key, 20)
    f32 = jnp.float32
    nrm = lambda k, shape, s: jax.random.normal(k, shape, f32) * s
    return {
        'x': nrm(ks[0], (BATCH, SEQ, D_MODEL), 1.0),
        'c': nrm(ks[1], (BATCH, D_MODEL), 1.0),
        'w_ada': nrm(ks[2], (DEPTH, D_MODEL, N_MOD * D_MODEL), 0.5 * D_MODEL ** -0.5),
        'b_ada': nrm(ks[3], (DEPTH, N_MOD * D_MODEL), 0.02),
        'norm_mix_in': 1.0 + nrm(ks[4], (DEPTH, D_MODEL), 0.02),
        'w_in': nrm(ks[5], (DEPTH, D_MODEL, IN_WIDTH), D_MODEL ** -0.5),
        'w_pool': nrm(ks[6], (DEPTH, POOL_GROUPS, POOL_GROUP_DIM, POOL_GROUP_DIM), POOL_GROUP_DIM ** -0.5),
        'pool_scale': 1.0 + nrm(ks[7], (DEPTH, POOL_WIDTH), 0.1),
        'sg_norm': 1.0 + nrm(ks[8], (DEPTH, SG_WIDTH), 0.02),
        'w_s': nrm(ks[9], (DEPTH, SG_HEADS, CHUNK, CHUNK), CHUNK ** -0.5),
        'b_s': 1.0 + nrm(ks[10], (DEPTH, SG_HEADS, CHUNK), 0.02),
        'mix_norm': 1.0 + nrm(ks[11], (DEPTH, MIX_WIDTH), 0.02),
        'w_out': nrm(ks[12], (DEPTH, MIX_WIDTH, D_MODEL), MIX_WIDTH ** -0.5),
        'norm_ffn_in': 1.0 + nrm(ks[13], (DEPTH, D_MODEL), 0.02),
        'w_gate_up': nrm(ks[14], (DEPTH, D_MODEL, 2 * D_FF), D_MODEL ** -0.5),
        'w_down': nrm(ks[15], (DEPTH, D_FF, D_MODEL), D_FF ** -0.5),
        'final_norm': 1.0 + nrm(ks[16], (D_MODEL,), 0.02),
    }


def reference(x, c, w_ada, b_ada, norm_mix_in, w_in, w_pool, pool_scale, sg_norm, w_s, b_s,
              mix_norm, w_out, norm_ffn_in, w_gate_up, w_down, final_norm):
    b, s, _ = x.shape
    c_act = jax.nn.silu(c)
    for l in range(DEPTH):
        mod = (c_act @ w_ada[l] + b_ada[l])[:, None, :]
        sh1, sc1, g1, sh2, sc2, g2 = jnp.split(mod, N_MOD, axis=-1)

        h = rmsnorm(x, norm_mix_in[l]) * (1.0 + sc1) + sh1
        proj = h @ w_in[l]
        q, k, v, p, u, vg = jnp.split(proj, SPLITS, axis=-1)
        a_out = stick_breaking_attention(q.reshape(b, s, SB_HEADS, HEAD_DIM),
                                         k.reshape(b, s, SB_HEADS, HEAD_DIM),
                                         v.reshape(b, s, SB_HEADS, HEAD_DIM))
        p_out = multiscale_pool(p, w_pool[l], pool_scale[l])
        g_out = chunked_spatial_gating(u, vg, sg_norm[l], w_s[l], b_s[l])
        mn = mix_norm[l]
        merged = jnp.concatenate([
            rmsnorm(a_out, mn[:SB_WIDTH]),
            rmsnorm(p_out, mn[SB_WIDTH:SB_WIDTH + POOL_WIDTH]),
            rmsnorm(g_out, mn[SB_WIDTH + POOL_WIDTH:]),
        ], axis=-1)
        x = x + g1 * (merged @ w_out[l])

        h2 = rmsnorm(x, norm_ffn_in[l]) * (1.0 + sc2) + sh2
        gate, up = jnp.split(h2 @ w_gate_up[l], 2, axis=-1)
        x = x + g2 * ((jax.nn.silu(gate) * up) @ w_down[l])
    return rmsnorm(x, final_norm)
```

```cpp
#include <hip/hip_runtime.h>
#include <hip/hip_cooperative_groups.h>
#include <cstdio>
#include <cstdint>
namespace cg = cooperative_groups;
#ifndef MK_MAX_STEP
#define MK_MAX_STEP 100
#define MK_PRO_MASK 7
#endif
#ifndef MK_ONE_LAUNCH
#define MK_ONE_LAUNCH 1
#endif
__device__ __forceinline__ int opaque_tid() { int t = threadIdx.x; asm volatile("" : "+v"(t)); return t; }
__device__ __forceinline__ int opaque_bid() { int b = blockIdx.x; asm volatile("" : "+s"(b)); return b; }
namespace pg8 {
#define PG8_LAS __attribute__((address_space(3)))
typedef unsigned short bf16_t;
typedef short bf16x8 __attribute__((ext_vector_type(8)));
typedef float f32x4 __attribute__((ext_vector_type(4)));
typedef unsigned u32x4 __attribute__((ext_vector_type(4)));
constexpr int BM = 256, BK = 64, HALF = 128, HTB = HALF * BK * 2  , STAGE_BYTES = 8 * HTB, NXCD = 8, WGM = 8;

__host__ __device__ __forceinline__ int lds_byte(int r, int c) { const int st = (r >> 4) * 2 + (c >> 5), rr = r & 15, cc = c & 31, ob = rr * 64 + cc * 2; return st * 1024 + (ob ^ (((ob >> 9) & 1) << 5)); }
__host__ __device__ __forceinline__ void stage_rc(int b, int& R, int& C) { const int st = b / 1024, sb = b % 1024, swz = sb ^ (((sb >> 9) & 1) << 5); R = (st >> 1) * 16 + swz / 64; C = (st & 1) * 32 + (swz % 64) / 2; }
__host__ __device__ __forceinline__ int perm32(int rho) { const int n = rho >> 4, i = rho & 15; return 8 * (i >> 2) + 4 * n + (i & 3); }

struct Unit { int pm, pn; };
struct Gemm { const bf16_t* A; const bf16_t* Bt; int M, N, K; };

struct StaticOrder {
    int nM, nN, nwg, G, c;
    __host__ __device__ void init(int M, int N, int G_, int c_) { nM = M / BM; nN = N / BM; nwg = nM * nN; G = G_; c = c_; }
    __host__ __device__ bool next(int i, Unit& u) const {
        const long L = (long)i * G + c; if (L >= nwg) return false;
        int wgid = (int)L; { const int q = nwg / NXCD, r = nwg % NXCD, xcd = wgid % NXCD, off = wgid / NXCD; wgid = (xcd < r ? xcd * (q + 1) : r * (q + 1) + (xcd - r) * q) + off; }
        const int nig = WGM * nN, gid = wgid / nig, fm = gid * WGM, gsz = (nM - fm) < WGM ? (nM - fm) : WGM;
        u.pm = fm + ((wgid % nig) % gsz); u.pn = (wgid % nig) / gsz; return true;
    }
    __device__ __forceinline__ void a_ready(const Unit&) const {}
    __device__ __forceinline__ void done(const Unit&) const {}
};

typedef float f32x2 __attribute__((ext_vector_type(2)));
typedef __bf16 bf16x2_t __attribute__((ext_vector_type(2)));
__device__ __forceinline__ unsigned cvt_pk_bf16(float lo, float hi) { f32x2 v = {lo, hi}; bf16x2_t b = __builtin_convertvector(v, bf16x2_t); return __builtin_bit_cast(unsigned, b); }
__device__ __forceinline__ float fast_sigmoid(float x) { return __builtin_amdgcn_rcpf(1.0f + __builtin_amdgcn_exp2f(-1.4426950408889634f * x)); }
__device__ __forceinline__ float gelu_tanh(float x) { const float u = 0.7978845608028654f * (x + 0.044715f * x * x * x); return x * fast_sigmoid(2.0f * u); }
__device__ __forceinline__ float silu_f(float x) { return x * fast_sigmoid(x); }

struct EpiProj {
    static constexpr bool PERM = true, AFTER_DRAIN = false;
    bf16_t* O;
    __device__ __forceinline__ void operator()(const f32x4 (&acc)[2][2][4][2], const Unit& u, int wr, int wc, int fr, int fq) const {
        const int row0 = u.pm * BM + wr * 64 + fr, col0 = u.pn * BM + wc * 32 + 8 * fq; const bool act = u.pn >= 7;
#pragma unroll
        for (int ai = 0; ai < 2; ++ai)
#pragma unroll
            for (int m = 0; m < 4; ++m) { bf16_t* rowp = O + (size_t)(row0 + ai * HALF + m * 16) * 2304 + col0;
#pragma unroll
                for (int bj = 0; bj < 2; ++bj) { f32x4 v0 = acc[ai][bj][m][0], v1 = acc[ai][bj][m][1];
                    if (act) { v0 = (f32x4){gelu_tanh(v0[0]), gelu_tanh(v0[1]), gelu_tanh(v0[2]), gelu_tanh(v0[3])}; v1 = (f32x4){gelu_tanh(v1[0]), gelu_tanh(v1[1]), gelu_tanh(v1[2]), gelu_tanh(v1[3])}; }
                    u32x4 w; w.x = cvt_pk_bf16(v0[0], v0[1]); w.y = cvt_pk_bf16(v0[2], v0[3]); w.z = cvt_pk_bf16(v1[0], v1[1]); w.w = cvt_pk_bf16(v1[2], v1[3]);
                    *(u32x4*)(rowp + bj * HALF) = w; } }
    }
};
struct EpiSwiglu {
    static constexpr bool PERM = true, AFTER_DRAIN = false;
    bf16_t* O;
    __device__ __forceinline__ void operator()(const f32x4 (&acc)[2][2][4][2], const Unit& u, int wr, int wc, int fr, int fq) const {
        const int row0 = u.pm * BM + wr * 64 + fr, col0 = u.pn * HALF + wc * 32 + 8 * fq;
#pragma unroll
        for (int ai = 0; ai < 2; ++ai)
#pragma unroll
            for (int m = 0; m < 4; ++m) { bf16_t* rowp = O + (size_t)(row0 + ai * HALF + m * 16) * 2816 + col0;
                const f32x4 g0 = acc[ai][0][m][0], g1 = acc[ai][0][m][1], u0 = acc[ai][1][m][0], u1 = acc[ai][1][m][1];
                u32x4 w; w.x = cvt_pk_bf16(silu_f(g0[0]) * u0[0], silu_f(g0[1]) * u0[1]); w.y = cvt_pk_bf16(silu_f(g0[2]) * u0[2], silu_f(g0[3]) * u0[3]);
                w.z = cvt_pk_bf16(silu_f(g1[0]) * u1[0], silu_f(g1[1]) * u1[1]); w.w = cvt_pk_bf16(silu_f(g1[2]) * u1[2], silu_f(g1[3]) * u1[3]);
                *(u32x4*)rowp = w; }
    }
};
struct EpiRes {
    static constexpr bool PERM = false, AFTER_DRAIN = false;
    const float* xin; float* xout; const float* gate;
    __device__ __forceinline__ void operator()(const f32x4 (&acc)[2][2][4][2], const Unit& u, int wr, int wc, int fr, int fq) const {
        const int col0 = u.pn * BM + wc * 32 + 4 * fq; const float* gp = gate + (size_t)(u.pm >> 5) * 6144 + col0;
        f32x4 gv[2][2];
#pragma unroll
        for (int bj = 0; bj < 2; ++bj)
#pragma unroll
            for (int n = 0; n < 2; ++n) gv[bj][n] = *(const f32x4*)(gp + bj * HALF + n * 16);
#pragma unroll
        for (int ai = 0; ai < 2; ++ai)
#pragma unroll
            for (int m = 0; m < 4; ++m) { const size_t off = (size_t)(u.pm * BM + ai * HALF + wr * 64 + m * 16 + fr) * 1024 + col0;
#pragma unroll
                for (int bj = 0; bj < 2; ++bj)
#pragma unroll
                    for (int n = 0; n < 2; ++n) { const f32x4 xv = *(const f32x4*)(xin + off + bj * HALF + n * 16);
                        *(f32x4*)(xout + off + bj * HALF + n * 16) = xv + gv[bj][n] * acc[ai][bj][m][n]; } }
    }
};
template <class Epi, class Sched, bool ALIGN_EPI = false, bool SP2 = false>
__device__ __forceinline__ void gemm_phase(PG8_LAS unsigned char* lds, const Gemm g, const Sched& S, const Epi& E) {
    const int tid = opaque_tid(), wid = __builtin_amdgcn_readfirstlane(tid >> 6), lane = tid & 63, wr = wid >> 2, wc = wid & 3, fr = lane & 15, fq = lane >> 4;
    const int K = g.K, nt = K / BK;
    unsigned voffA[2], voffB[2];
#pragma unroll
    for (int i = 0; i < 2; ++i) { int R, C; stage_rc(tid * 16 + i * 8192, R, C); const int Rb = Epi::PERM ? ((R & ~31) + perm32(R & 31)) : R;
        voffA[i] = (unsigned)(R * K + C) * 2u; voffB[i] = (unsigned)(Rb * K + C) * 2u; }
    const size_t kstep = (size_t)(BK * 2);
    const size_t hstep = (size_t)HALF * K * 2;
    const size_t tstep = 2 * hstep;
    const unsigned ldsw = (unsigned)wid * 1024u;
    const int aoff = lds_byte(wr * 64 + fr, fq * 8), boff = lds_byte(wc * 32 + fr, fq * 8);
#define PG8_SA(b, h) (((b) * 2 + (h)) * HTB)
#define PG8_SB(b, h) ((4 + (b) * 2 + (h)) * HTB)
#define PG8_STAGE(bufoff, gbase, voff) do { _Pragma("unroll") for (int _i = 0; _i < 2; ++_i) \
        __builtin_amdgcn_global_load_lds((const unsigned*)((const char*)(gbase) + (voff)[_i]), (PG8_LAS unsigned*)(lds + (bufoff) + ldsw + _i * 8192), 16, 0, 0); } while (0)
#define PG8_LDA(dst, b, h) do { _Pragma("unroll") for (int m = 0; m < 4; ++m) _Pragma("unroll") for (int k = 0; k < 2; ++k) dst[m][k] = *(const PG8_LAS bf16x8*)(lds + PG8_SA(b, h) + aoff + m * 2048 + k * 1024); } while (0)
#define PG8_LDB(dst, b, h) do { _Pragma("unroll") for (int n = 0; n < 2; ++n) _Pragma("unroll") for (int k = 0; k < 2; ++k) dst[n][k] = *(const PG8_LAS bf16x8*)(lds + PG8_SB(b, h) + boff + n * 2048 + k * 1024); } while (0)
#define PG8_MMA(ai, bj, At, Bt) do { __builtin_amdgcn_s_setprio(1); _Pragma("unroll") for (int m = 0; m < 4; ++m) _Pragma("unroll") for (int n = 0; n < 2; ++n) _Pragma("unroll") for (int k = 0; k < 2; ++k) \
        acc[ai][bj][m][n] = __builtin_amdgcn_mfma_f32_16x16x32_bf16(Bt[n][k], At[m][k], acc[ai][bj][m][n], 0, 0, 0); __builtin_amdgcn_s_setprio(0); } while (0)
#define PG8_WAIT_V(n) asm volatile("s_waitcnt vmcnt(" #n ")" ::: "memory")
#define PG8_WAIT_L(n) asm volatile("s_waitcnt lgkmcnt(" #n ")" ::: "memory")
#define PG8_BAR __builtin_amdgcn_s_barrier()
#define PG8_SCHED __builtin_amdgcn_sched_barrier(0)
    Unit cur, nxt; int ui = 0;
    if (!S.next(0, cur)) return;
    f32x4 acc[2][2][4][2];
#pragma unroll
    for (int a = 0; a < 2; ++a)
#pragma unroll
        for (int b = 0; b < 2; ++b)
#pragma unroll
            for (int m = 0; m < 4; ++m)
#pragma unroll
                for (int n = 0; n < 2; ++n) acc[a][b][m][n] = (f32x4){0.f, 0.f, 0.f, 0.f};
    bf16x8 At[4][2], B0[2][2], B1[2][2];
    const char* cA = (const char*)g.A + (size_t)cur.pm * tstep; const char* cB = (const char*)g.Bt + (size_t)cur.pn * tstep;
    S.a_ready(cur);
    if constexpr (SP2) {
        PG8_STAGE(PG8_SB(0, 0), cB, voffB); PG8_STAGE(PG8_SB(0, 1), cB + hstep, voffB); PG8_STAGE(PG8_SA(0, 0), cA, voffA); PG8_STAGE(PG8_SA(0, 1), cA + hstep, voffA);
        if (wr == 1) PG8_BAR;
        PG8_WAIT_V(2); PG8_BAR;
        PG8_STAGE(PG8_SB(1, 0), cB + kstep, voffB); PG8_STAGE(PG8_SA(1, 0), cA + kstep, voffA); PG8_STAGE(PG8_SB(1, 1), cB + hstep + kstep, voffB);
        PG8_WAIT_V(6); PG8_BAR;
    } else {
        PG8_STAGE(PG8_SB(0, 0), cB, voffB); PG8_STAGE(PG8_SA(0, 0), cA, voffA); PG8_STAGE(PG8_SB(0, 1), cB + hstep, voffB); PG8_STAGE(PG8_SA(0, 1), cA + hstep, voffA);
        if (wr == 1) PG8_BAR;
        PG8_WAIT_V(4); PG8_BAR;
        PG8_STAGE(PG8_SB(1, 0), cB + kstep, voffB); PG8_STAGE(PG8_SA(1, 0), cA + kstep, voffA); PG8_STAGE(PG8_SB(1, 1), cB + hstep + kstep, voffB);
        PG8_WAIT_V(6); PG8_BAR;
    }
    for (;;) {
        const bool has_next = S.next(ui + 1, nxt);
        const char* nA = has_next ? (const char*)g.A + (size_t)nxt.pm * tstep : cA; const char* nB = has_next ? (const char*)g.Bt + (size_t)nxt.pn * tstep : cB;
        for (int t = 0; t < nt; t += 2) {
            const bool last = (t == nt - 2);
            const char* a1 = cA + (size_t)(t + 1) * kstep;
            const char* a2 = last ? nA : cA + (size_t)(t + 2) * kstep; const char* b2 = last ? nB : cB + (size_t)(t + 2) * kstep;
            const char* a3 = a2 + kstep; const char* b3 = b2 + kstep;
            if (last && has_next) S.a_ready(nxt);
            if constexpr (SP2) {
            PG8_LDB(B0, 0, 0); PG8_LDB(B1, 0, 1); PG8_SCHED; PG8_LDA(At, 0, 0); PG8_STAGE(PG8_SA(1, 1), a1 + hstep, voffA);
            PG8_WAIT_V(8); PG8_WAIT_L(0); PG8_BAR; PG8_MMA(0, 0, At, B0); PG8_MMA(0, 1, At, B1); PG8_BAR; PG8_SCHED;
            PG8_LDA(At, 0, 1); PG8_STAGE(PG8_SB(0, 0), b2, voffB); PG8_STAGE(PG8_SB(0, 1), b2 + hstep, voffB); PG8_STAGE(PG8_SA(0, 0), a2, voffA);
            PG8_WAIT_V(8); PG8_WAIT_L(0); PG8_BAR; PG8_MMA(1, 0, At, B0); PG8_MMA(1, 1, At, B1); PG8_BAR; PG8_SCHED;
            PG8_LDB(B0, 1, 0); PG8_LDB(B1, 1, 1); PG8_SCHED; PG8_LDA(At, 1, 0); PG8_STAGE(PG8_SA(0, 1), a2 + hstep, voffA);
            PG8_WAIT_V(8); PG8_WAIT_L(0); PG8_BAR; PG8_MMA(0, 0, At, B0); PG8_MMA(0, 1, At, B1); PG8_BAR; PG8_SCHED;
            PG8_LDA(At, 1, 1); PG8_STAGE(PG8_SB(1, 0), b3, voffB); PG8_STAGE(PG8_SB(1, 1), b3 + hstep, voffB); PG8_STAGE(PG8_SA(1, 0), a3, voffA);
            PG8_WAIT_V(8); PG8_WAIT_L(0); PG8_BAR; PG8_MMA(1, 0, At, B0); PG8_MMA(1, 1, At, B1); PG8_BAR; PG8_SCHED;
            } else {
            PG8_LDB(B0, 0, 0); PG8_SCHED; PG8_LDA(At, 0, 0); PG8_STAGE(PG8_SA(1, 1), a1 + hstep, voffA);
            PG8_WAIT_L(8); PG8_BAR; PG8_WAIT_L(0); PG8_MMA(0, 0, At, B0); PG8_BAR; PG8_SCHED;
            PG8_LDB(B1, 0, 1); PG8_STAGE(PG8_SB(0, 0), b2, voffB);
            PG8_BAR; PG8_WAIT_L(0); PG8_MMA(0, 1, At, B1); PG8_BAR;
            PG8_LDA(At, 0, 1); PG8_STAGE(PG8_SA(0, 0), a2, voffA);
            PG8_BAR; PG8_WAIT_L(0); PG8_MMA(1, 0, At, B0); PG8_BAR; PG8_SCHED;
            PG8_STAGE(PG8_SB(0, 1), b2 + hstep, voffB);
            PG8_WAIT_V(6); PG8_BAR; PG8_MMA(1, 1, At, B1); PG8_BAR;
            PG8_LDB(B0, 1, 0); PG8_SCHED; PG8_LDA(At, 1, 0); PG8_STAGE(PG8_SA(0, 1), a2 + hstep, voffA);
            PG8_WAIT_L(8); PG8_BAR; PG8_WAIT_L(0); PG8_MMA(0, 0, At, B0); PG8_BAR; PG8_SCHED;
            PG8_LDB(B1, 1, 1); PG8_STAGE(PG8_SB(1, 0), b3, voffB);
            PG8_BAR; PG8_WAIT_L(0); PG8_MMA(0, 1, At, B1); PG8_BAR;
            PG8_LDA(At, 1, 1); PG8_STAGE(PG8_SA(1, 0), a3, voffA);
            PG8_BAR; PG8_WAIT_L(0); PG8_MMA(1, 0, At, B0); PG8_BAR; PG8_SCHED;
            PG8_STAGE(PG8_SB(1, 1), b3 + hstep, voffB);
            PG8_WAIT_V(6); PG8_BAR; PG8_MMA(1, 1, At, B1); PG8_BAR;
            }
        }
        if constexpr (ALIGN_EPI) { if (wr == 0) PG8_BAR; }
        if constexpr (!Epi::AFTER_DRAIN) { E(acc, cur, wr, wc, fr, fq); S.done(cur); }
        if (!has_next) break;
#pragma unroll
        for (int a = 0; a < 2; ++a)
#pragma unroll
            for (int b = 0; b < 2; ++b)
#pragma unroll
                for (int m = 0; m < 4; ++m)
#pragma unroll
                    for (int n = 0; n < 2; ++n) acc[a][b][m][n] = (f32x4){0.f, 0.f, 0.f, 0.f};
        cur = nxt; cA = nA; cB = nB; ++ui;
        if constexpr (ALIGN_EPI) { if (wr == 1) PG8_BAR; }
    }
    PG8_WAIT_V(0);
    if constexpr (!ALIGN_EPI) { if (wr == 0) PG8_BAR; }
    PG8_BAR;
    if constexpr (Epi::AFTER_DRAIN) { E.fused(acc, cur, wr, wc, fr, fq, lds, wid, lane); S.done(cur); }
#undef PG8_SA
#undef PG8_SB
#undef PG8_STAGE
#undef PG8_LDA
#undef PG8_LDB
#undef PG8_MMA
#undef PG8_WAIT_V
#undef PG8_WAIT_L
#undef PG8_BAR
#undef PG8_SCHED
}
}
#define LAS __attribute__((address_space(3)))
typedef unsigned short bf16_t;
typedef short bf16x8 __attribute__((ext_vector_type(8)));
typedef short s16x4 __attribute__((ext_vector_type(4)));
typedef float f32x4 __attribute__((ext_vector_type(4)));
typedef float f32x16 __attribute__((ext_vector_type(16)));
typedef unsigned u32x4 __attribute__((ext_vector_type(4)));
typedef unsigned u32x2 __attribute__((ext_vector_type(2)));
using pg8::cvt_pk_bf16;
constexpr int NB = 8, SEQ = 8192, D = 1024, M = NB * SEQ, INW = 2304, FF = 2816, GU = 2 * FF, DEPTH = 4, NMOD = 6144;
constexpr float EPS = 1e-6f;
constexpr size_t MiB = 1u << 20;
constexpr size_t WS_MOD = 0;
constexpr size_t WS_WSB = 1 * MiB;
constexpr size_t WS_WPB = WS_WSB + 512 * 1024;
constexpr size_t WS_W = 2 * MiB;
constexpr size_t W_IN_OFF = 0, W_OUT_OFF = 5 * MiB, W_GU_OFF = 7 * MiB, W_DN_OFF = 18 * MiB, W_LAYER = 23 * MiB + 512 * 1024;
constexpr size_t WS_H = 96 * MiB;
constexpr size_t WS_P = 224 * MiB;
constexpr size_t WS_END = 576 * MiB;
static_assert(WS_W + 4 * W_LAYER <= WS_H && WS_H + (size_t)M * D * 2 <= WS_P && WS_P + (size_t)M * FF * 2 <= WS_END, "ws map");
constexpr int LDS_BYTES = 147456;
constexpr int NTHREADS = 512;

struct Args { const float* in[17]; float* out; unsigned char* ws; int ph_lo, ph_hi; };

__device__ __forceinline__ float wave_sum(float v) {
#pragma unroll
    for (int o = 1; o < 64; o <<= 1) v += __shfl_xor(v, o);
    return v;
}
__device__ __forceinline__ float bf2f(unsigned short b) { return __uint_as_float((unsigned)b << 16); }
__device__ __forceinline__ float bflo(unsigned w) { return __uint_as_float(w << 16); }
__device__ __forceinline__ float bfhi(unsigned w) { return __uint_as_float(w & 0xffff0000u); }
__device__ __forceinline__ int crow(int reg, int h) { return (reg & 3) + 8 * (reg >> 2) + 4 * h; }
#define MFMA32(a, b, c) __builtin_amdgcn_mfma_f32_32x32x16_bf16((a), (b), (c), 0, 0, 0)
typedef short v4i16_t __attribute__((ext_vector_type(4)));
__device__ __forceinline__ s16x4 vtr(LAS const unsigned char* p) { return __builtin_bit_cast(s16x4, __builtin_amdgcn_ds_read_tr16_b64_v4i16((LAS v4i16_t*)p)); }
__device__ __forceinline__ bf16x8 cat8(s16x4 lo, s16x4 hi) { return __builtin_shufflevector(lo, hi, 0, 1, 2, 3, 4, 5, 6, 7); }

__device__ __forceinline__ void phase_pro(const Args& a, LAS unsigned char* lds) {
    const int tid = opaque_tid(), G = gridDim.x, bid = opaque_bid();
    LAS float* sc = (LAS float*)lds; LAS float* red = (LAS float*)(lds + 32768);
    { const float* c = a.in[1];
      for (int i = tid; i < NB * D; i += NTHREADS) { const float v = c[i]; sc[i] = v * pg8::fast_sigmoid(v); } }
    __syncthreads();
    float* mod = (float*)(a.ws + WS_MOD);
    if (MK_PRO_MASK & 1)
    for (int item = bid; item < DEPTH * 192; item += G) {
        const int l = item / 192, cgp = item % 192, kp = tid >> 3, n4 = tid & 7;
        float acc[8][4];
#pragma unroll
        for (int b = 0; b < 8; ++b)
#pragma unroll
            for (int j = 0; j < 4; ++j) acc[b][j] = 0.f;
        const float* wp = a.in[2] + ((size_t)l * D + kp * 16) * NMOD + cgp * 32 + n4 * 4;
#pragma unroll 4
        for (int k = 0; k < 16; ++k) {
            const f32x4 w = *(const f32x4*)(wp + (size_t)k * NMOD);
#pragma unroll
            for (int b = 0; b < 8; ++b) { const float s = sc[b * D + kp * 16 + k]; acc[b][0] += s * w[0]; acc[b][1] += s * w[1]; acc[b][2] += s * w[2]; acc[b][3] += s * w[3]; }
        }
#pragma unroll
        for (int b = 0; b < 8; ++b)
#pragma unroll
            for (int j = 0; j < 4; ++j) red[(kp * 8 + b) * 32 + n4 * 4 + j] = acc[b][j];
        __syncthreads();
        if (tid < 256) { const int b = tid >> 5, col = tid & 31; float s = 0.f;
            for (int k2 = 0; k2 < 64; ++k2) s += red[(k2 * 8 + b) * 32 + col];
            mod[(size_t)(l * 8 + b) * NMOD + cgp * 32 + col] = s + a.in[3][l * NMOD + cgp * 32 + col]; }
        __syncthreads();
    }
    LAS float* tile = (LAS float*)lds;
    if (MK_PRO_MASK & 2)
    for (int it = bid; it < DEPTH * 2944; it += G) {
        const int l = it / 2944; int r = it % 2944;
        const float* W; int K, N, kt, nt, kind = 0; size_t woff;
        if (r < 576) { W = a.in[5] + (size_t)l * D * INW; K = D; N = INW; kt = r / 36; nt = r % 36; woff = W_IN_OFF; }
        else if (r < 832) { r -= 576; W = a.in[12] + (size_t)l * D * D; K = D; N = D; kt = r / 16; nt = r % 16; woff = W_OUT_OFF; }
        else if (r < 2240) { r -= 832; W = a.in[14] + (size_t)l * D * GU; K = D; N = GU; kt = r / 88; nt = r % 88; woff = W_GU_OFF; kind = 1; }
        else { r -= 2240; W = a.in[15] + (size_t)l * FF * D; K = FF; N = D; kt = r / 16; nt = r % 16; woff = W_DN_OFF; }
        bf16_t* WT = (bf16_t*)(a.ws + WS_W + (size_t)l * W_LAYER + woff);
        const int n0 = nt * 64, k0 = kt * 64;
        int dn0 = n0;
        if (kind == 1) { dn0 = n0 < FF ? (n0 / 128) * 256 + (n0 % 128) : ((n0 - FF) / 128) * 256 + 128 + ((n0 - FF) % 128); }
#pragma unroll
        for (int p = 0; p < 2; ++p) { const int row = (tid >> 4) + 32 * p, c4 = tid & 15;
            const f32x4 v = *(const f32x4*)(W + (size_t)(k0 + row) * N + n0 + 4 * c4);
            tile[row * 65 + 4 * c4 + 0] = v[0]; tile[row * 65 + 4 * c4 + 1] = v[1]; tile[row * 65 + 4 * c4 + 2] = v[2]; tile[row * 65 + 4 * c4 + 3] = v[3]; }
        __syncthreads();
        { const int n = tid >> 3, kc = tid & 7; LAS const float* s = tile + (8 * kc) * 65 + n;
          u32x4 o; o.x = cvt_pk_bf16(s[0], s[65]); o.y = cvt_pk_bf16(s[2 * 65], s[3 * 65]); o.z = cvt_pk_bf16(s[4 * 65], s[5 * 65]); o.w = cvt_pk_bf16(s[6 * 65], s[7 * 65]);
          *(u32x4*)(WT + (size_t)(dn0 + n) * K + k0 + 8 * kc) = o; }
        __syncthreads();
    }
    if (MK_PRO_MASK & 4)
    { const float* ws_ = a.in[9]; bf16_t* wsb = (bf16_t*)(a.ws + WS_WSB);
      for (int i = bid * NTHREADS + tid; i < DEPTH * 4 * 128 * 128; i += G * NTHREADS) { const int s = i & 127, t = (i >> 7) & 127; const float v = (s <= t) ? ws_[i] : 0.f; wsb[i] = (bf16_t)(cvt_pk_bf16(v, 0.f) & 0xffffu); }
      const float* wp_ = a.in[6]; bf16_t* wpb = (bf16_t*)(a.ws + WS_WPB);
      for (int i = bid * NTHREADS + tid; i < DEPTH * 4 * 64 * 64; i += G * NTHREADS) { const int c = i & 63, e = (i >> 6) & 63, lg = i >> 12; wpb[i] = (bf16_t)(cvt_pk_bf16(wp_[(lg * 64 + c) * 64 + e], 0.f) & 0xffffu); } }
}

__device__ __forceinline__ void phase_norm(const float* xin, const float* g, const float* sh, const float* sc, bf16_t* hout) {
    const int tid = opaque_tid(), lane = tid & 63, wave = tid >> 6, gw = opaque_bid() * 8 + wave, NGW = gridDim.x * 8;
    const int b = gw & 7, r0 = gw >> 3, rstep = NGW >> 3;
    f32x4 gs[4], sv[4];
#pragma unroll
    for (int j = 0; j < 4; ++j) { const int col = 4 * lane + 256 * j; const f32x4 gg = *(const f32x4*)(g + col), ss = *(const f32x4*)(sc + (size_t)b * NMOD + col);
        gs[j] = gg * (ss + 1.0f); sv[j] = *(const f32x4*)(sh + (size_t)b * NMOD + col); }
    for (int r = r0; r < SEQ; r += rstep) {
        const size_t row = (size_t)b * SEQ + r; const f32x4* xr = (const f32x4*)(xin + row * D) + lane;
        f32x4 v[4]; float s = 0.f;
#pragma unroll
        for (int j = 0; j < 4; ++j) { v[j] = xr[64 * j]; s += (v[j][0] * v[j][0] + v[j][1] * v[j][1]) + (v[j][2] * v[j][2] + v[j][3] * v[j][3]); }
        const float rstd = __builtin_amdgcn_rsqf(wave_sum(s) * (1.0f / D) + EPS);
        u32x2* o = (u32x2*)(hout + row * D) + lane;
#pragma unroll
        for (int j = 0; j < 4; ++j) { const f32x4 y = v[j] * rstd * gs[j] + sv[j]; u32x2 w; w.x = cvt_pk_bf16(y[0], y[1]); w.y = cvt_pk_bf16(y[2], y[3]); o[64 * j] = w; }
    }
}
__device__ __forceinline__ void phase_final(const float* xin, const float* g, float* out) {
    const int tid = opaque_tid(), lane = tid & 63, wave = tid >> 6, gw = opaque_bid() * 8 + wave, NGW = gridDim.x * 8;
    f32x4 gs[4];
#pragma unroll
    for (int j = 0; j < 4; ++j) gs[j] = *(const f32x4*)(g + 4 * lane + 256 * j);
    for (int row = gw; row < M; row += NGW) {
        const f32x4* xr = (const f32x4*)(xin + (size_t)row * D) + lane; f32x4 v[4]; float s = 0.f;
#pragma unroll
        for (int j = 0; j < 4; ++j) { v[j] = xr[64 * j]; s += (v[j][0] * v[j][0] + v[j][1] * v[j][1]) + (v[j][2] * v[j][2] + v[j][3] * v[j][3]); }
        const float rstd = __builtin_amdgcn_rsqf(wave_sum(s) * (1.0f / D) + EPS);
        f32x4* o = (f32x4*)(out + (size_t)row * D) + lane;
#pragma unroll
        for (int j = 0; j < 4; ++j) o[64 * j] = v[j] * rstd * gs[j];
    }
}
__device__ __forceinline__ void attn_unit(int unit, const bf16_t* proj, bf16_t* merged, const float* mn, LAS unsigned char* lds, int wave, int lane) {
    const int b = unit >> 8, q0 = (unit & 255) * 32, n = lane & 31, h = lane >> 5, hd = wave;
    const size_t rowbase = (size_t)b * SEQ;
    constexpr float C1 = 0.125f * 1.4426950408889634f;
    bf16x8 bq[4];
    { const bf16_t* qp = proj + (rowbase + q0 + n) * INW + hd * 64 + 8 * h;
#pragma unroll
      for (int s = 0; s < 4; ++s) bq[s] = *(const bf16x8*)(qp + 16 * s); }
    f32x16 o0, o1;
#pragma unroll
    for (int i = 0; i < 16; ++i) { o0[i] = 0.f; o1[i] = 0.f; }
    float carry = 0.f;
    LAS unsigned char* kl = lds + wave * 9216; LAS unsigned char* vl = kl + 4608;
    const int nkt = min(17, (q0 >> 5) + 1);
    const int q4 = (lane & 15) >> 2, p4 = lane & 3, blk = (lane >> 4) & 1;
    for (int kt = 0; kt < nkt; ++kt) {
        const int k0 = q0 - 32 * kt;
        const bf16_t* kp = proj + (rowbase + k0) * INW + 512 + hd * 64;
        u32x4 kv[4], vv[4];
#pragma unroll
        for (int i = 0; i < 4; ++i) { const int c = lane + 64 * i, row = c >> 3, ch = c & 7; kv[i] = *(const u32x4*)(kp + (size_t)row * INW + ch * 8); vv[i] = *(const u32x4*)(kp + 512 + (size_t)row * INW + ch * 8); }
#pragma unroll
        for (int i = 0; i < 4; ++i) { const int c = lane + 64 * i, row = c >> 3, ch = c & 7; *(LAS u32x4*)(kl + row * 144 + ch * 16) = kv[i]; *(LAS u32x4*)(vl + row * 144 + ch * 16) = vv[i]; }
        asm volatile("s_waitcnt lgkmcnt(0)" ::: "memory");
        f32x16 st;
#pragma unroll
        for (int i = 0; i < 16; ++i) st[i] = 0.f;
#pragma unroll
        for (int s = 0; s < 4; ++s) { const bf16x8 ka = *(LAS const bf16x8*)(kl + n * 144 + (2 * s + h) * 16); st = MFMA32(ka, bq[s], st); }
        float y[16], lr[16], w[16];
#pragma unroll
        for (int i = 0; i < 16; ++i) {
            y[i] = st[i] * C1;
            const float sp = fmaxf(y[i], 0.f) + __builtin_amdgcn_logf(1.0f + __builtin_amdgcn_exp2f(-fabsf(y[i])));
            bool valid = true;
            if (kt == 0) valid = crow(i, h) < n;
            if (kt == 16) valid = crow(i, h) >= n;
            lr[i] = valid ? -sp : 0.f;
        }
        const float G0 = (lr[0] + lr[1]) + (lr[2] + lr[3]), G1 = (lr[4] + lr[5]) + (lr[6] + lr[7]), G2 = (lr[8] + lr[9]) + (lr[10] + lr[11]), G3 = (lr[12] + lr[13]) + (lr[14] + lr[15]);
        const float P0 = __shfl_xor(G0, 32), P1 = __shfl_xor(G1, 32), P2 = __shfl_xor(G2, 32), P3 = __shfl_xor(G3, 32);
        const float S2 = G3 + P3, S1 = S2 + (G2 + P2), S0 = S1 + (G1 + P1), tot = S0 + (G0 + P0);
        float T[4]; T[0] = S0 + (h == 0 ? P0 : 0.f); T[1] = S1 + (h == 0 ? P1 : 0.f); T[2] = S2 + (h == 0 ? P2 : 0.f); T[3] = (h == 0 ? P3 : 0.f);
#pragma unroll
        for (int g = 0; g < 4; ++g) {
            float later = carry + T[g];
#pragma unroll
            for (int j = 3; j >= 0; --j) { const int i = 4 * g + j;
                bool valid = true;
                if (kt == 0) valid = crow(i, h) < n;
                if (kt == 16) valid = crow(i, h) >= n;
                w[i] = valid ? __builtin_amdgcn_exp2f(lr[i] + y[i] + later) : 0.f;
                later += lr[i]; }
        }
        carry += tot;
        bf16x8 wf[2];
#pragma unroll
        for (int s = 0; s < 2; ++s) { u32x4 p; p.x = cvt_pk_bf16(w[8 * s], w[8 * s + 1]); p.y = cvt_pk_bf16(w[8 * s + 2], w[8 * s + 3]); p.z = cvt_pk_bf16(w[8 * s + 4], w[8 * s + 5]); p.w = cvt_pk_bf16(w[8 * s + 6], w[8 * s + 7]); wf[s] = __builtin_bit_cast(bf16x8, p); }
#pragma unroll
        for (int s = 0; s < 2; ++s) {
            LAS const unsigned char* vb = vl + (16 * s + 4 * h + q4) * 144 + 32 * blk + 8 * p4;
            const s16x4 lo0 = vtr(vb), hi0 = vtr(vb + 8 * 144), lo1 = vtr(vb + 64), hi1 = vtr(vb + 8 * 144 + 64);
            o0 = MFMA32(cat8(lo0, hi0), wf[s], o0);
            o1 = MFMA32(cat8(lo1, hi1), wf[s], o1);
        }
        asm volatile("" ::: "memory");
    }
    float ss = 0.f;
#pragma unroll
    for (int i = 0; i < 16; ++i) ss += o0[i] * o0[i] + o1[i] * o1[i];
    ss += __shfl_xor(ss, 32);
    LAS float* ex = (LAS float*)(lds + 73728);
    if (h == 0) ex[wave * 32 + n] = ss;
    __syncthreads();
    float tot = 0.f;
#pragma unroll
    for (int w8 = 0; w8 < 8; ++w8) tot += ex[w8 * 32 + n];
    const float rstd = __builtin_amdgcn_rsqf(tot * (1.0f / 512.0f) + EPS);
    bf16_t* op = merged + (rowbase + q0 + n) * D + hd * 64 + 4 * h;
    const float* mp = mn + hd * 64 + 4 * h;
#pragma unroll
    for (int g = 0; g < 4; ++g) {
        const f32x4 m0 = *(const f32x4*)(mp + 8 * g), m1 = *(const f32x4*)(mp + 32 + 8 * g);
        u32x2 a0, a1;
        a0.x = cvt_pk_bf16(o0[4 * g] * rstd * m0[0], o0[4 * g + 1] * rstd * m0[1]); a0.y = cvt_pk_bf16(o0[4 * g + 2] * rstd * m0[2], o0[4 * g + 3] * rstd * m0[3]);
        a1.x = cvt_pk_bf16(o1[4 * g] * rstd * m1[0], o1[4 * g + 1] * rstd * m1[1]); a1.y = cvt_pk_bf16(o1[4 * g + 2] * rstd * m1[2], o1[4 * g + 3] * rstd * m1[3]);
        *(u32x2*)(op + 8 * g) = a0; *(u32x2*)(op + 32 + 8 * g) = a1;
    }
    __syncthreads();
}

__device__ __forceinline__ void sg_unit(int unit, const bf16_t* proj, bf16_t* merged, const float* mn, const float* sgn, const bf16_t* wsb, const float* bs, LAS unsigned char* lds, int tid, int wave, int lane) {
    const size_t R0 = (size_t)unit * 128;
    constexpr int RS = 528;
    { const int t = tid >> 2, part = tid & 3;
      const bf16_t* vp = proj + (R0 + t) * INW + 2048 + 64 * part;
      u32x4 raw[8];
#pragma unroll
      for (int i = 0; i < 8; ++i) raw[i] = *(const u32x4*)(vp + 8 * i);
      float s = 0.f;
#pragma unroll
      for (int i = 0; i < 8; ++i) s += (bflo(raw[i].x) + bfhi(raw[i].x)) + (bflo(raw[i].y) + bfhi(raw[i].y)) + (bflo(raw[i].z) + bfhi(raw[i].z)) + (bflo(raw[i].w) + bfhi(raw[i].w));
      s += __shfl_xor(s, 1); s += __shfl_xor(s, 2);
      const float mean = s * (1.0f / 256.0f);
      float q = 0.f;
#pragma unroll
      for (int i = 0; i < 8; ++i) { float d;
          d = bflo(raw[i].x) - mean; q += d * d; d = bfhi(raw[i].x) - mean; q += d * d; d = bflo(raw[i].y) - mean; q += d * d; d = bfhi(raw[i].y) - mean; q += d * d;
          d = bflo(raw[i].z) - mean; q += d * d; d = bfhi(raw[i].z) - mean; q += d * d; d = bflo(raw[i].w) - mean; q += d * d; d = bfhi(raw[i].w) - mean; q += d * d; }
      q += __shfl_xor(q, 1); q += __shfl_xor(q, 2);
      const float rstd = __builtin_amdgcn_rsqf(q * (1.0f / 256.0f) + EPS);
      const float* gp = sgn + 64 * part;
#pragma unroll
      for (int i = 0; i < 8; ++i) { const f32x4 ga = *(const f32x4*)(gp + 8 * i), gb = *(const f32x4*)(gp + 8 * i + 4); u32x4 o;
          o.x = cvt_pk_bf16((bflo(raw[i].x) - mean) * rstd * ga[0], (bfhi(raw[i].x) - mean) * rstd * ga[1]); o.y = cvt_pk_bf16((bflo(raw[i].y) - mean) * rstd * ga[2], (bfhi(raw[i].y) - mean) * rstd * ga[3]);
          o.z = cvt_pk_bf16((bflo(raw[i].z) - mean) * rstd * gb[0], (bfhi(raw[i].z) - mean) * rstd * gb[1]); o.w = cvt_pk_bf16((bflo(raw[i].w) - mean) * rstd * gb[2], (bfhi(raw[i].w) - mean) * rstd * gb[3]);
          *(LAS u32x4*)(lds + t * RS + 2 * (64 * part + 8 * i)) = o; }
    }
    __syncthreads();
    const int h4 = wave >> 1, dh = wave & 1, n = lane & 31, h = lane >> 5, cbase = 64 * h4 + 32 * dh;
    const int q4 = (lane & 15) >> 2, p4 = lane & 3, blk = (lane >> 4) & 1;
    f32x16 acc[4];
#pragma unroll
    for (int tt = 0; tt < 4; ++tt)
#pragma unroll
        for (int i = 0; i < 16; ++i) acc[tt][i] = 0.f;
#pragma unroll
    for (int ks = 0; ks < 8; ++ks) {
        LAS const unsigned char* vb = lds + (16 * ks + 8 * h + q4) * RS + 2 * (cbase + 16 * blk) + 8 * p4;
        const bf16x8 af = cat8(vtr(vb), vtr(vb + 4 * RS));
#pragma unroll
        for (int tt = 0; tt < 4; ++tt) if (ks < 2 * (tt + 1)) {
            const bf16x8 bfr = *(const bf16x8*)(wsb + (size_t)(h4 * 128 + 32 * tt + n) * 128 + 16 * ks + 8 * h);
            acc[tt] = MFMA32(af, bfr, acc[tt]); }
    }
    LAS float* ex = (LAS float*)(lds + 67584);
#pragma unroll
    for (int tt = 0; tt < 4; ++tt) { const int t = 32 * tt + n; const float bias = bs[h4 * 128 + t]; const bf16_t* up = proj + (R0 + t) * INW + 1792 + cbase + 4 * h; float s = 0.f;
#pragma unroll
        for (int g = 0; g < 4; ++g) { const u32x2 uu = *(const u32x2*)(up + 8 * g);
            const float v0 = bflo(uu.x) * (acc[tt][4 * g] + bias), v1 = bfhi(uu.x) * (acc[tt][4 * g + 1] + bias), v2 = bflo(uu.y) * (acc[tt][4 * g + 2] + bias), v3 = bfhi(uu.y) * (acc[tt][4 * g + 3] + bias);
            acc[tt][4 * g] = v0; acc[tt][4 * g + 1] = v1; acc[tt][4 * g + 2] = v2; acc[tt][4 * g + 3] = v3; s += (v0 * v0 + v1 * v1) + (v2 * v2 + v3 * v3); }
        s += __shfl_xor(s, 32);
        if (h == 0) ex[wave * 128 + t] = s; }
    __syncthreads();
#pragma unroll
    for (int tt = 0; tt < 4; ++tt) { const int t = 32 * tt + n; float tot = 0.f;
#pragma unroll
        for (int w8 = 0; w8 < 8; ++w8) tot += ex[w8 * 128 + t];
        const float rstd = __builtin_amdgcn_rsqf(tot * (1.0f / 256.0f) + EPS);
        bf16_t* op = merged + (R0 + t) * D + 768 + cbase + 4 * h; const float* mp = mn + 768 + cbase + 4 * h;
#pragma unroll
        for (int g = 0; g < 4; ++g) { const f32x4 m0 = *(const f32x4*)(mp + 8 * g); u32x2 a0;
            a0.x = cvt_pk_bf16(acc[tt][4 * g] * rstd * m0[0], acc[tt][4 * g + 1] * rstd * m0[1]); a0.y = cvt_pk_bf16(acc[tt][4 * g + 2] * rstd * m0[2], acc[tt][4 * g + 3] * rstd * m0[3]);
            *(u32x2*)(op + 8 * g) = a0; } }
    __syncthreads();
}

__device__ __forceinline__ void pool_unit(int unit, const bf16_t* proj, bf16_t* merged, const float* mn, const bf16_t* wpb, const float* pscale, LAS unsigned char* lds, int tid, int wave, int lane) {
    const size_t T0 = (size_t)unit * 128; const int pos0 = (unit & 63) * 128;
    constexpr int RS = 528;
    for (int c = tid; c < 144 * 32; c += NTHREADS) { const int li = c >> 5, ch = c & 31; u32x4 v = (u32x4){0u, 0u, 0u, 0u};
        if (li >= 16 || pos0 > 0) v = *(const u32x4*)(proj + (T0 + li - 16) * INW + 1536 + 8 * ch);
        *(LAS u32x4*)(lds + li * RS + 16 * ch) = v; }
    __syncthreads();
    const int g = wave >> 1, eh = wave & 1, n = lane & 31, h = lane >> 5, W = 2 << g;
    f32x16 acc[4];
#pragma unroll
    for (int tt = 0; tt < 4; ++tt)
#pragma unroll
        for (int i = 0; i < 16; ++i) acc[tt][i] = 0.f;
    bf16x8 af[4];
#pragma unroll
    for (int ks = 0; ks < 4; ++ks) af[ks] = *(const bf16x8*)(wpb + (size_t)(g * 64 + 32 * eh + n) * 64 + 16 * ks + 8 * h);
#pragma unroll
    for (int tt = 0; tt < 4; ++tt) {
        const int li = 16 + 32 * tt + n, pos = pos0 + 32 * tt + n; const float inv = 1.0f / (float)min(pos + 1, W);
#pragma unroll
        for (int ks = 0; ks < 4; ++ks) {
            LAS const unsigned char* pb = lds + li * RS + 2 * (64 * g + 16 * ks + 8 * h);
            float sm[8];
#pragma unroll
            for (int k = 0; k < 8; ++k) sm[k] = 0.f;
            for (int j = 0; j < W; ++j) { const u32x4 v = *(LAS const u32x4*)(pb - j * RS);
                sm[0] += bflo(v.x); sm[1] += bfhi(v.x); sm[2] += bflo(v.y); sm[3] += bfhi(v.y); sm[4] += bflo(v.z); sm[5] += bfhi(v.z); sm[6] += bflo(v.w); sm[7] += bfhi(v.w); }
            const u32x4 own = *(LAS const u32x4*)pb; u32x4 p;
            p.x = cvt_pk_bf16(sm[0] * inv - bflo(own.x), sm[1] * inv - bfhi(own.x)); p.y = cvt_pk_bf16(sm[2] * inv - bflo(own.y), sm[3] * inv - bfhi(own.y));
            p.z = cvt_pk_bf16(sm[4] * inv - bflo(own.z), sm[5] * inv - bfhi(own.z)); p.w = cvt_pk_bf16(sm[6] * inv - bflo(own.w), sm[7] * inv - bfhi(own.w));
            acc[tt] = MFMA32(af[ks], __builtin_bit_cast(bf16x8, p), acc[tt]);
        }
    }
    LAS float* ex = (LAS float*)(lds + 76032);
    const int ebase = 64 * g + 32 * eh + 4 * h;
#pragma unroll
    for (int tt = 0; tt < 4; ++tt) { float s = 0.f;
#pragma unroll
        for (int gg = 0; gg < 4; ++gg) { const f32x4 ps = *(const f32x4*)(pscale + ebase + 8 * gg);
#pragma unroll
            for (int j = 0; j < 4; ++j) { const float v = acc[tt][4 * gg + j] * ps[j]; acc[tt][4 * gg + j] = v; s += v * v; } }
        s += __shfl_xor(s, 32);
        if (h == 0) ex[wave * 128 + 32 * tt + n] = s; }
    __syncthreads();
#pragma unroll
    for (int tt = 0; tt < 4; ++tt) { const int t = 32 * tt + n; float tot = 0.f;
#pragma unroll
        for (int w8 = 0; w8 < 8; ++w8) tot += ex[w8 * 128 + t];
        const float rstd = __builtin_amdgcn_rsqf(tot * (1.0f / 256.0f) + EPS);
        bf16_t* op = merged + (T0 + t) * D + 512 + ebase; const float* mp = mn + 512 + ebase;
#pragma unroll
        for (int gg = 0; gg < 4; ++gg) { const f32x4 m0 = *(const f32x4*)(mp + 8 * gg); u32x2 a0;
            a0.x = cvt_pk_bf16(acc[tt][4 * gg] * rstd * m0[0], acc[tt][4 * gg + 1] * rstd * m0[1]); a0.y = cvt_pk_bf16(acc[tt][4 * gg + 2] * rstd * m0[2], acc[tt][4 * gg + 3] * rstd * m0[3]);
            *(u32x2*)(op + 8 * gg) = a0; } }
    __syncthreads();
}

__device__ __forceinline__ void phase_mix(const Args& a, int l, LAS unsigned char* lds) {
    const int tid = opaque_tid(), lane = tid & 63, wave = __builtin_amdgcn_readfirstlane(tid >> 6), G = gridDim.x, bid = opaque_bid();
    const bf16_t* proj = (const bf16_t*)(a.ws + WS_P); bf16_t* merged = (bf16_t*)(a.ws + WS_H);
    const float* mn = a.in[11] + (size_t)l * D;
    for (int u = bid; u < M / 32; u += G) attn_unit(u, proj, merged, mn, lds, wave, lane);
    { const float* sgn = a.in[8] + l * 256; const bf16_t* wsb = (const bf16_t*)(a.ws + WS_WSB) + (size_t)l * 4 * 128 * 128; const float* bs = a.in[10] + l * 4 * 128;
      for (int u = bid; u < M / 128; u += G) sg_unit(u, proj, merged, mn, sgn, wsb, bs, lds, tid, wave, lane); }
    { const bf16_t* wpb = (const bf16_t*)(a.ws + WS_WPB) + (size_t)l * 4 * 64 * 64; const float* pscale = a.in[7] + l * 256;
      for (int u = bid; u < M / 128; u += G) pool_unit(u, proj, merged, mn, wpb, pscale, lds, tid, wave, lane); }
}
constexpr int N_STEPS = 2 + 7 * DEPTH;
__global__ void __launch_bounds__(NTHREADS, 2) fwd(Args args) {
    extern __shared__ __attribute__((aligned(16))) unsigned char lds_raw[];
    LAS unsigned char* lds = (LAS unsigned char*)lds_raw;
#if MK_ONE_LAUNCH
#define SEAM() do { __syncthreads(); cg::this_grid().sync(); } while (0)
#else
#define SEAM() do { } while (0)
#endif
#define RUN(k) (args.ph_lo <= (k) && (k) < args.ph_hi && (k) < MK_MAX_STEP)
    unsigned char* ws = args.ws;
    const float* mod = (const float*)(ws + WS_MOD);
    bf16_t* hbuf = (bf16_t*)(ws + WS_H); bf16_t* pbuf = (bf16_t*)(ws + WS_P);
    if (RUN(0)) phase_pro(args, lds);
    SEAM();
#pragma nounroll
    for (int l = 0; l < DEPTH; ++l) {
        const int s0 = 1 + 7 * l;
        const float* xin = (l == 0) ? args.in[0] : args.out;
        const float* modl = mod + (size_t)l * 8 * NMOD;
        const unsigned char* wl = ws + WS_W + (size_t)l * W_LAYER;
        if (RUN(s0 + 0)) phase_norm(xin, args.in[4] + l * D, modl, modl + 1024, hbuf);
        SEAM();
        if (RUN(s0 + 1)) { pg8::Gemm g{hbuf, (const bf16_t*)(wl + W_IN_OFF), M, INW, D}; pg8::StaticOrder S; S.init(M, INW, gridDim.x, opaque_bid()); pg8::EpiProj E{pbuf};
            pg8::gemm_phase<pg8::EpiProj, pg8::StaticOrder, true, true>(lds, g, S, E); }
        SEAM();
        if (RUN(s0 + 2)) phase_mix(args, l, lds);
        SEAM();
        if (RUN(s0 + 3)) { pg8::Gemm g{hbuf, (const bf16_t*)(wl + W_OUT_OFF), M, D, D}; pg8::StaticOrder S; S.init(M, D, gridDim.x, opaque_bid()); pg8::EpiRes E{xin, args.out, modl + 2048};
            pg8::gemm_phase<pg8::EpiRes, pg8::StaticOrder, true, true>(lds, g, S, E); }
        SEAM();
        if (RUN(s0 + 4)) phase_norm(args.out, args.in[13] + l * D, modl + 3072, modl + 4096, hbuf);
        SEAM();
        if (RUN(s0 + 5)) { pg8::Gemm g{hbuf, (const bf16_t*)(wl + W_GU_OFF), M, GU, D}; pg8::StaticOrder S; S.init(M, GU, gridDim.x, opaque_bid()); pg8::EpiSwiglu E{pbuf};
            pg8::gemm_phase<pg8::EpiSwiglu, pg8::StaticOrder, true, true>(lds, g, S, E); }
        SEAM();
        if (RUN(s0 + 6)) { pg8::Gemm g{pbuf, (const bf16_t*)(wl + W_DN_OFF), M, D, FF}; pg8::StaticOrder S; S.init(M, D, gridDim.x, opaque_bid()); pg8::EpiRes E{args.out, args.out, modl + 5120};
            pg8::gemm_phase<pg8::EpiRes, pg8::StaticOrder, true, true>(lds, g, S, E); }
        SEAM();
    }
    if (RUN(N_STEPS - 1)) phase_final(args.out, args.in[16], args.out);
#undef RUN
#undef SEAM
}

extern "C" void kernel_launch(void* const* d_in, const int* in_sizes, int n_in, void* d_out, int out_size, void* d_ws, size_t ws_size, hipStream_t stream) {
    static int grid = 0;
    if (grid == 0) {
        if (n_in != 17 || in_sizes[0] != M * D || out_size != M * D || ws_size < WS_END) { fprintf(stderr, "kernel_launch: unexpected shapes (n_in %d in0 %d out %d ws %zu)\n", n_in, n_in > 0 ? in_sizes[0] : -1, out_size, ws_size); grid = -1; return; }
        int dev = 0, cus = 0, per_cu = 0;
        if (hipGetDevice(&dev) != hipSuccess || hipDeviceGetAttribute(&cus, hipDeviceAttributeMultiprocessorCount, dev) != hipSuccess) { grid = -1; return; }
        if (hipFuncSetAttribute((const void*)fwd, hipFuncAttributeMaxDynamicSharedMemorySize, LDS_BYTES) != hipSuccess) { fprintf(stderr, "kernel_launch: hipFuncSetAttribute failed\n"); grid = -1; return; }
        if (hipOccupancyMaxActiveBlocksPerMultiprocessor(&per_cu, (const void*)fwd, NTHREADS, LDS_BYTES) != hipSuccess || per_cu < 1) { fprintf(stderr, "kernel_launch: occupancy query gave %d\n", per_cu); per_cu = 1; }
        (void)hipGetLastError();
        grid = cus * per_cu;
    }
    if (grid < 0) return;
    Args a{};
    for (int i = 0; i < 17; ++i) a.in[i] = (const float*)d_in[i];
    a.out = (float*)d_out; a.ws = (unsigned char*)d_ws;
#if MK_ONE_LAUNCH
    a.ph_lo = 0; a.ph_hi = N_STEPS;
    void* params[] = {&a};
    hipError_t e = hipLaunchCooperativeKernel((const void*)fwd, dim3(grid), dim3(NTHREADS), params, LDS_BYTES, stream);
    if (e != hipSuccess) fprintf(stderr, "cooperative launch failed: %s (grid %d)\n", hipGetErrorString(e), grid);
#else
    for (int k = 0; k < N_STEPS && k < (MK_MAX_STEP > 0 ? MK_MAX_STEP : 1); ++k) { a.ph_lo = k; a.ph_hi = k + 1; hipLaunchKernelGGL(fwd, dim3(grid), dim3(NTHREADS), LDS_BYTES, stream, a); }
#endif
}
```

```cpp
#include <hip/hip_runtime.h>
#include <hip/hip_cooperative_groups.h>
#include <cstdio>
#include <cstdint>
namespace cg = cooperative_groups;
#ifndef MK_MAX_STEP
#define MK_MAX_STEP 100
#define MK_PRO_MASK 7
#endif
#ifndef MK_ONE_LAUNCH
#define MK_ONE_LAUNCH 1
#endif
__device__ __forceinline__ int opaque_tid() { int t = threadIdx.x; asm volatile("" : "+v"(t)); return t; }
__device__ __forceinline__ int opaque_bid() { int b = blockIdx.x; asm volatile("" : "+s"(b)); return b; }
namespace pg8 {
#define PG8_LAS __attribute__((address_space(3)))
typedef unsigned short bf16_t;
typedef short bf16x8 __attribute__((ext_vector_type(8)));
typedef float f32x4 __attribute__((ext_vector_type(4)));
typedef unsigned u32x4 __attribute__((ext_vector_type(4)));
constexpr int BM = 256, BK = 64, HALF = 128, HTB = HALF * BK * 2  , STAGE_BYTES = 8 * HTB, NXCD = 8, WGM = 8;

__host__ __device__ __forceinline__ int lds_byte(int r, int c) { const int st = (r >> 4) * 2 + (c >> 5), rr = r & 15, cc = c & 31, ob = rr * 64 + cc * 2; return st * 1024 + (ob ^ (((ob >> 9) & 1) << 5)); }
__host__ __device__ __forceinline__ void stage_rc(int b, int& R, int& C) { const int st = b / 1024, sb = b % 1024, swz = sb ^ (((sb >> 9) & 1) << 5); R = (st >> 1) * 16 + swz / 64; C = (st & 1) * 32 + (swz % 64) / 2; }
__host__ __device__ __forceinline__ int perm32(int rho) { const int n = rho >> 4, i = rho & 15; return 8 * (i >> 2) + 4 * n + (i & 3); }

struct Unit { int pm, pn; };
struct Gemm { const bf16_t* A; const bf16_t* Bt; int M, N, K; };

struct StaticOrder {
    int nM, nN, nwg, G, c;
    __host__ __device__ void init(int M, int N, int G_, int c_) { nM = M / BM; nN = N / BM; nwg = nM * nN; G = G_; c = c_; }
    __host__ __device__ bool next(int i, Unit& u) const {
        const long L = (long)i * G + c; if (L >= nwg) return false;
        int wgid = (int)L; { const int q = nwg / NXCD, r = nwg % NXCD, xcd = wgid % NXCD, off = wgid / NXCD; wgid = (xcd < r ? xcd * (q + 1) : r * (q + 1) + (xcd - r) * q) + off; }
        const int nig = WGM * nN, gid = wgid / nig, fm = gid * WGM, gsz = (nM - fm) < WGM ? (nM - fm) : WGM;
        u.pm = fm + ((wgid % nig) % gsz); u.pn = (wgid % nig) / gsz; return true;
    }
    __device__ __forceinline__ void a_ready(const Unit&) const {}
    __device__ __forceinline__ void done(const Unit&) const {}
};

typedef float f32x2 __attribute__((ext_vector_type(2)));
typedef __bf16 bf16x2_t __attribute__((ext_vector_type(2)));
__device__ __forceinline__ unsigned cvt_pk_bf16(float lo, float hi) { f32x2 v = {lo, hi}; bf16x2_t b = __builtin_convertvector(v, bf16x2_t); return __builtin_bit_cast(unsigned, b); }
__device__ __forceinline__ float fast_sigmoid(float x) { return __builtin_amdgcn_rcpf(1.0f + __builtin_amdgcn_exp2f(-1.4426950408889634f * x)); }
__device__ __forceinline__ float gelu_tanh(float x) { const float u = 0.7978845608028654f * (x + 0.044715f * x * x * x); return x * fast_sigmoid(2.0f * u); }
__device__ __forceinline__ float silu_f(float x) { return x * fast_sigmoid(x); }

struct EpiProj {
    static constexpr bool PERM = true, AFTER_DRAIN = false;
    bf16_t* O;
    __device__ __forceinline__ void operator()(const f32x4 (&acc)[2][2][4][2], const Unit& u, int wr, int wc, int fr, int fq) const {
        const int row0 = u.pm * BM + wr * 64 + fr, col0 = u.pn * BM + wc * 32 + 8 * fq; const bool act = u.pn >= 7;
#pragma unroll
        for (int ai = 0; ai < 2; ++ai)
#pragma unroll
            for (int m = 0; m < 4; ++m) { bf16_t* rowp = O + (size_t)(row0 + ai * HALF + m * 16) * 2304 + col0;
#pragma unroll
                for (int bj = 0; bj < 2; ++bj) { f32x4 v0 = acc[ai][bj][m][0], v1 = acc[ai][bj][m][1];
                    if (act) { v0 = (f32x4){gelu_tanh(v0[0]), gelu_tanh(v0[1]), gelu_tanh(v0[2]), gelu_tanh(v0[3])}; v1 = (f32x4){gelu_tanh(v1[0]), gelu_tanh(v1[1]), gelu_tanh(v1[2]), gelu_tanh(v1[3])}; }
                    u32x4 w; w.x = cvt_pk_bf16(v0[0], v0[1]); w.y = cvt_pk_bf16(v0[2], v0[3]); w.z = cvt_pk_bf16(v1[0], v1[1]); w.w = cvt_pk_bf16(v1[2], v1[3]);
                    *(u32x4*)(rowp + bj * HALF) = w; } }
    }
};
struct EpiSwiglu {
    static constexpr bool PERM = true, AFTER_DRAIN = false;
    bf16_t* O;
    __device__ __forceinline__ void operator()(const f32x4 (&acc)[2][2][4][2], const Unit& u, int wr, int wc, int fr, int fq) const {
        const int row0 = u.pm * BM + wr * 64 + fr, col0 = u.pn * HALF + wc * 32 + 8 * fq;
#pragma unroll
        for (int ai = 0; ai < 2; ++ai)
#pragma unroll
            for (int m = 0; m < 4; ++m) { bf16_t* rowp = O + (size_t)(row0 + ai * HALF + m * 16) * 2816 + col0;
                const f32x4 g0 = acc[ai][0][m][0], g1 = acc[ai][0][m][1], u0 = acc[ai][1][m][0], u1 = acc[ai][1][m][1];
                u32x4 w; w.x = cvt_pk_bf16(silu_f(g0[0]) * u0[0], silu_f(g0[1]) * u0[1]); w.y = cvt_pk_bf16(silu_f(g0[2]) * u0[2], silu_f(g0[3]) * u0[3]);
                w.z = cvt_pk_bf16(silu_f(g1[0]) * u1[0], silu_f(g1[1]) * u1[1]); w.w = cvt_pk_bf16(silu_f(g1[2]) * u1[2], silu_f(g1[3]) * u1[3]);
                *(u32x4*)rowp = w; }
    }
};
struct EpiRes {
    static constexpr bool PERM = false, AFTER_DRAIN = false;
    const float* xin; float* xout; const float* gate;
    __device__ __forceinline__ void operator()(const f32x4 (&acc)[2][2][4][2], const Unit& u, int wr, int wc, int fr, int fq) const {
        const int col0 = u.pn * BM + wc * 32 + 4 * fq; const float* gp = gate + (size_t)(u.pm >> 5) * 6144 + col0;
        f32x4 gv[2][2];
#pragma unroll
        for (int bj = 0; bj < 2; ++bj)
#pragma unroll
            for (int n = 0; n < 2; ++n) gv[bj][n] = *(const f32x4*)(gp + bj * HALF + n * 16);
#pragma unroll
        for (int ai = 0; ai < 2; ++ai)
#pragma unroll
            for (int m = 0; m < 4; ++m) { const size_t off = (size_t)(u.pm * BM + ai * HALF + wr * 64 + m * 16 + fr) * 1024 + col0;
#pragma unroll
                for (int bj = 0; bj < 2; ++bj)
#pragma unroll
                    for (int n = 0; n < 2; ++n) { const f32x4 xv = *(const f32x4*)(xin + off + bj * HALF + n * 16);
                        *(f32x4*)(xout + off + bj * HALF + n * 16) = xv + gv[bj][n] * acc[ai][bj][m][n]; } }
    }
};
template <class Epi, class Sched, bool ALIGN_EPI = false, bool SP2 = false>
__device__ __forceinline__ void gemm_phase(PG8_LAS unsigned char* lds, const Gemm g, const Sched& S, const Epi& E) {
    const int tid = opaque_tid(), wid = __builtin_amdgcn_readfirstlane(tid >> 6), lane = tid & 63, wr = wid >> 2, wc = wid & 3, fr = lane & 15, fq = lane >> 4;
    const int K = g.K, nt = K / BK;
    unsigned voffA[2], voffB[2];
#pragma unroll
    for (int i = 0; i < 2; ++i) { int R, C; stage_rc(tid * 16 + i * 8192, R, C); const int Rb = Epi::PERM ? ((R & ~31) + perm32(R & 31)) : R;
        voffA[i] = (unsigned)(R * K + C) * 2u; voffB[i] = (unsigned)(Rb * K + C) * 2u; }
    const size_t kstep = (size_t)(BK * 2);
    const size_t hstep = (size_t)HALF * K * 2;
    const size_t tstep = 2 * hstep;
    const unsigned ldsw = (unsigned)wid * 1024u;
    const int aoff = lds_byte(wr * 64 + fr, fq * 8), boff = lds_byte(wc * 32 + fr, fq * 8);
#define PG8_SA(b, h) (((b) * 2 + (h)) * HTB)
#define PG8_SB(b, h) ((4 + (b) * 2 + (h)) * HTB)
#define PG8_STAGE(bufoff, gbase, voff) do { _Pragma("unroll") for (int _i = 0; _i < 2; ++_i) \
        __builtin_amdgcn_global_load_lds((const unsigned*)((const char*)(gbase) + (voff)[_i]), (PG8_LAS unsigned*)(lds + (bufoff) + ldsw + _i * 8192), 16, 0, 0); } while (0)
#define PG8_LDA(dst, b, h) do { _Pragma("unroll") for (int m = 0; m < 4; ++m) _Pragma("unroll") for (int k = 0; k < 2; ++k) dst[m][k] = *(const PG8_LAS bf16x8*)(lds + PG8_SA(b, h) + aoff + m * 2048 + k * 1024); } while (0)
#define PG8_LDB(dst, b, h) do { _Pragma("unroll") for (int n = 0; n < 2; ++n) _Pragma("unroll") for (int k = 0; k < 2; ++k) dst[n][k] = *(const PG8_LAS bf16x8*)(lds + PG8_SB(b, h) + boff + n * 2048 + k * 1024); } while (0)
#define PG8_MMA(ai, bj, At, Bt) do { __builtin_amdgcn_s_setprio(1); _Pragma("unroll") for (int m = 0; m < 4; ++m) _Pragma("unroll") for (int n = 0; n < 2; ++n) _Pragma("unroll") for (int k = 0; k < 2; ++k) \
        acc[ai][bj][m][n] = __builtin_amdgcn_mfma_f32_16x16x32_bf16(Bt[n][k], At[m][k], acc[ai][bj][m][n], 0, 0, 0); __builtin_amdgcn_s_setprio(0); } while (0)
#define PG8_WAIT_V(n) asm volatile("s_waitcnt vmcnt(" #n ")" ::: "memory")
#define PG8_WAIT_L(n) asm volatile("s_waitcnt lgkmcnt(" #n ")" ::: "memory")
#define PG8_BAR __builtin_amdgcn_s_barrier()
#define PG8_SCHED __builtin_amdgcn_sched_barrier(0)
    Unit cur, nxt; int ui = 0;
    if (!S.next(0, cur)) return;
    f32x4 acc[2][2][4][2];
#pragma unroll
    for (int a = 0; a < 2; ++a)
#pragma unroll
        for (int b = 0; b < 2; ++b)
#pragma unroll
            for (int m = 0; m < 4; ++m)
#pragma unroll
                for (int n = 0; n < 2; ++n) acc[a][b][m][n] = (f32x4){0.f, 0.f, 0.f, 0.f};
    bf16x8 At[4][2], B0[2][2], B1[2][2];
    const char* cA = (const char*)g.A + (size_t)cur.pm * tstep; const char* cB = (const char*)g.Bt + (size_t)cur.pn * tstep;
    S.a_ready(cur);
    if constexpr (SP2) {
        PG8_STAGE(PG8_SB(0, 0), cB, voffB); PG8_STAGE(PG8_SB(0, 1), cB + hstep, voffB); PG8_STAGE(PG8_SA(0, 0), cA, voffA); PG8_STAGE(PG8_SA(0, 1), cA + hstep, voffA);
        if (wr == 1) PG8_BAR;
        PG8_WAIT_V(2); PG8_BAR;
        PG8_STAGE(PG8_SB(1, 0), cB + kstep, voffB); PG8_STAGE(PG8_SA(1, 0), cA + kstep, voffA); PG8_STAGE(PG8_SB(1, 1), cB + hstep + kstep, voffB);
        PG8_WAIT_V(6); PG8_BAR;
    } else {
        PG8_STAGE(PG8_SB(0, 0), cB, voffB); PG8_STAGE(PG8_SA(0, 0), cA, voffA); PG8_STAGE(PG8_SB(0, 1), cB + hstep, voffB); PG8_STAGE(PG8_SA(0, 1), cA + hstep, voffA);
        if (wr == 1) PG8_BAR;
        PG8_WAIT_V(4); PG8_BAR;
        PG8_STAGE(PG8_SB(1, 0), cB + kstep, voffB); PG8_STAGE(PG8_SA(1, 0), cA + kstep, voffA); PG8_STAGE(PG8_SB(1, 1), cB + hstep + kstep, voffB);
        PG8_WAIT_V(6); PG8_BAR;
    }
    for (;;) {
        const bool has_next = S.next(ui + 1, nxt);
        const char* nA = has_next ? (const char*)g.A + (size_t)nxt.pm * tstep : cA; const char* nB = has_next ? (const char*)g.Bt + (size_t)nxt.pn * tstep : cB;
        for (int t = 0; t < nt; t += 2) {
            const bool last = (t == nt - 2);
            const char* a1 = cA + (size_t)(t + 1) * kstep;
            const char* a2 = last ? nA : cA + (size_t)(t + 2) * kstep; const char* b2 = last ? nB : cB + (size_t)(t + 2) * kstep;
            const char* a3 = a2 + kstep; const char* b3 = b2 + kstep;
            if (last && has_next) S.a_ready(nxt);
            if constexpr (SP2) {
            PG8_LDB(B0, 0, 0); PG8_LDB(B1, 0, 1); PG8_SCHED; PG8_LDA(At, 0, 0); PG8_STAGE(PG8_SA(1, 1), a1 + hstep, voffA);
            PG8_WAIT_V(8); PG8_WAIT_L(0); PG8_BAR; PG8_MMA(0, 0, At, B0); PG8_MMA(0, 1, At, B1); PG8_BAR; PG8_SCHED;
            PG8_LDA(At, 0, 1); PG8_STAGE(PG8_SB(0, 0), b2, voffB); PG8_STAGE(PG8_SB(0, 1), b2 + hstep, voffB); PG8_STAGE(PG8_SA(0, 0), a2, voffA);
            PG8_WAIT_V(8); PG8_WAIT_L(0); PG8_BAR; PG8_MMA(1, 0, At, B0); PG8_MMA(1, 1, At, B1); PG8_BAR; PG8_SCHED;
            PG8_LDB(B0, 1, 0); PG8_LDB(B1, 1, 1); PG8_SCHED; PG8_LDA(At, 1, 0); PG8_STAGE(PG8_SA(0, 1), a2 + hstep, voffA);
            PG8_WAIT_V(8); PG8_WAIT_L(0); PG8_BAR; PG8_MMA(0, 0, At, B0); PG8_MMA(0, 1, At, B1); PG8_BAR; PG8_SCHED;
            PG8_LDA(At, 1, 1); PG8_STAGE(PG8_SB(1, 0), b3, voffB); PG8_STAGE(PG8_SB(1, 1), b3 + hstep, voffB); PG8_STAGE(PG8_SA(1, 0), a3, voffA);
            PG8_WAIT_V(8); PG8_WAIT_L(0); PG8_BAR; PG8_MMA(1, 0, At, B0); PG8_MMA(1, 1, At, B1); PG8_BAR; PG8_SCHED;
            } else {
            PG8_LDB(B0, 0, 0); PG8_SCHED; PG8_LDA(At, 0, 0); PG8_STAGE(PG8_SA(1, 1), a1 + hstep, voffA);
            PG8_WAIT_L(8); PG8_BAR; PG8_WAIT_L(0); PG8_MMA(0, 0, At, B0); PG8_BAR; PG8_SCHED;
            PG8_LDB(B1, 0, 1); PG8_STAGE(PG8_SB(0, 0), b2, voffB);
            PG8_BAR; PG8_WAIT_L(0); PG8_MMA(0, 1, At, B1); PG8_BAR;
            PG8_LDA(At, 0, 1); PG8_STAGE(PG8_SA(0, 0), a2, voffA);
            PG8_BAR; PG8_WAIT_L(0); PG8_MMA(1, 0, At, B0); PG8_BAR; PG8_SCHED;
            PG8_STAGE(PG8_SB(0, 1), b2 + hstep, voffB);
            PG8_WAIT_V(6); PG8_BAR; PG8_MMA(1, 1, At, B1); PG8_BAR;
            PG8_LDB(B0, 1, 0); PG8_SCHED; PG8_LDA(At, 1, 0); PG8_STAGE(PG8_SA(0, 1), a2 + hstep, voffA);
            PG8_WAIT_L(8); PG8_BAR; PG8_WAIT_L(0); PG8_MMA(0, 0, At, B0); PG8_BAR; PG8_SCHED;
            PG8_LDB(B1, 1, 1); PG8_STAGE(PG8_SB(1, 0), b3, voffB);
            PG8_BAR; PG8_WAIT_L(0); PG8_MMA(0, 1, At, B1); PG8_BAR;
            PG8_LDA(At, 1, 1); PG8_STAGE(PG8_SA(1, 0), a3, voffA);
            PG8_BAR; PG8_WAIT_L(0); PG8_MMA(1, 0, At, B0); PG8_BAR; PG8_SCHED;
            PG8_STAGE(PG8_SB(1, 1), b3 + hstep, voffB);
            PG8_WAIT_V(6); PG8_BAR; PG8_MMA(1, 1, At, B1); PG8_BAR;
            }
        }
        if constexpr (ALIGN_EPI) { if (wr == 0) PG8_BAR; }
        if constexpr (!Epi::AFTER_DRAIN) { E(acc, cur, wr, wc, fr, fq); S.done(cur); }
        if (!has_next) break;
#pragma unroll
        for (int a = 0; a < 2; ++a)
#pragma unroll
            for (int b = 0; b < 2; ++b)
#pragma unroll
                for (int m = 0; m < 4; ++m)
#pragma unroll
                    for (int n = 0; n < 2; ++n) acc[a][b][m][n] = (f32x4){0.f, 0.f, 0.f, 0.f};
        cur = nxt; cA = nA; cB = nB; ++ui;
        if constexpr (ALIGN_EPI) { if (wr == 1) PG8_BAR; }
    }
    PG8_WAIT_V(0);
    if constexpr (!ALIGN_EPI) { if (wr == 0) PG8_BAR; }
    PG8_BAR;
    if constexpr (Epi::AFTER_DRAIN) { E.fused(acc, cur, wr, wc, fr, fq, lds, wid, lane); S.done(cur); }
#undef PG8_SA
#undef PG8_SB
#undef PG8_STAGE
#undef PG8_LDA
#undef PG8_LDB
#undef PG8_MMA
#undef PG8_WAIT_V
#undef PG8_WAIT_L
#undef PG8_BAR
#undef PG8_SCHED
}
}
#define LAS __attribute__((address_space(3)))
typedef unsigned short bf16_t;
typedef short bf16x8 __attribute__((ext_vector_type(8)));
typedef short s16x4 __attribute__((ext_vector_type(4)));
typedef float f32x4 __attribute__((ext_vector_type(4)));
typedef float f32x16 __attribute__((ext_vector_type(16)));
typedef unsigned u32x4 __attribute__((ext_vector_type(4)));
typedef unsigned u32x2 __attribute__((ext_vector_type(2)));
using pg8::cvt_pk_bf16;
constexpr int NB = 8, SEQ = 8192, D = 1024, M = NB * SEQ, INW = 2304, FF = 2816, GU = 2 * FF, DEPTH = 4, NMOD = 6144;
constexpr float EPS = 1e-6f;
constexpr size_t MiB = 1u << 20;
constexpr size_t WS_MOD = 0;
constexpr size_t WS_WSB = 1 * MiB;
constexpr size_t WS_WPB = WS_WSB + 512 * 1024;
constexpr size_t WS_W = 2 * MiB;
constexpr size_t W_IN_OFF = 0, W_OUT_OFF = 5 * MiB, W_GU_OFF = 7 * MiB, W_DN_OFF = 18 * MiB, W_LAYER = 23 * MiB + 512 * 1024;
constexpr size_t WS_H = 96 * MiB;
constexpr size_t WS_P = 224 * MiB;
constexpr size_t WS_END = 576 * MiB;
constexpr size_t WS_BAR = WS_END;
static_assert(WS_W + 4 * W_LAYER <= WS_H && WS_H + (size_t)M * D * 2 <= WS_P && WS_P + (size_t)M * FF * 2 <= WS_END, "ws map");
constexpr int LDS_BYTES = 147456;
constexpr int NTHREADS = 512;

__device__ __forceinline__ void grid_bar(unsigned* ctr, unsigned& target) {
    target += gridDim.x;
    asm volatile("s_waitcnt vmcnt(0)" ::: "memory");
    __syncthreads();
    if (threadIdx.x == 0) {
        __builtin_amdgcn_fence(__ATOMIC_RELEASE, "agent");
        asm volatile("s_waitcnt vmcnt(0)" ::: "memory");
        __hip_atomic_fetch_add(ctr, 1u, __ATOMIC_RELAXED, __HIP_MEMORY_SCOPE_AGENT);
        while (__hip_atomic_load(ctr, __ATOMIC_RELAXED, __HIP_MEMORY_SCOPE_AGENT) < target) __builtin_amdgcn_s_sleep(1);
        __builtin_amdgcn_fence(__ATOMIC_ACQUIRE, "agent");
        asm volatile("s_waitcnt vmcnt(0)" ::: "memory");
    }
    __syncthreads();
}
struct Args { const float* in[17]; float* out; unsigned char* ws; int ph_lo, ph_hi; };

__device__ __forceinline__ float wave_sum(float v) {
#pragma unroll
    for (int o = 1; o < 64; o <<= 1) v += __shfl_xor(v, o);
    return v;
}
__device__ __forceinline__ float bf2f(unsigned short b) { return __uint_as_float((unsigned)b << 16); }
__device__ __forceinline__ float bflo(unsigned w) { return __uint_as_float(w << 16); }
__device__ __forceinline__ float bfhi(unsigned w) { return __uint_as_float(w & 0xffff0000u); }
__device__ __forceinline__ int crow(int reg, int h) { return (reg & 3) + 8 * (reg >> 2) + 4 * h; }
#define MFMA32(a, b, c) __builtin_amdgcn_mfma_f32_32x32x16_bf16((a), (b), (c), 0, 0, 0)
typedef short v4i16_t __attribute__((ext_vector_type(4)));
__device__ __forceinline__ s16x4 vtr(LAS const unsigned char* p) { return __builtin_bit_cast(s16x4, __builtin_amdgcn_ds_read_tr16_b64_v4i16((LAS v4i16_t*)p)); }
__device__ __forceinline__ bf16x8 cat8(s16x4 lo, s16x4 hi) { return __builtin_shufflevector(lo, hi, 0, 1, 2, 3, 4, 5, 6, 7); }

__device__ __forceinline__ void phase_pro(const Args& a, LAS unsigned char* lds) {
    const int tid = opaque_tid(), G = gridDim.x, bid = opaque_bid();
    LAS float* sc = (LAS float*)lds; LAS float* red = (LAS float*)(lds + 32768);
    { const float* c = a.in[1];
      for (int i = tid; i < NB * D; i += NTHREADS) { const float v = c[i]; sc[i] = v * pg8::fast_sigmoid(v); } }
    __syncthreads();
    float* mod = (float*)(a.ws + WS_MOD);
    if (MK_PRO_MASK & 1)
    for (int item = bid; item < DEPTH * 192; item += G) {
        const int l = item / 192, cgp = item % 192, kp = tid >> 3, n4 = tid & 7;
        float acc[8][4];
#pragma unroll
        for (int b = 0; b < 8; ++b)
#pragma unroll
            for (int j = 0; j < 4; ++j) acc[b][j] = 0.f;
        const float* wp = a.in[2] + ((size_t)l * D + kp * 16) * NMOD + cgp * 32 + n4 * 4;
#pragma unroll 4
        for (int k = 0; k < 16; ++k) {
            const f32x4 w = *(const f32x4*)(wp + (size_t)k * NMOD);
#pragma unroll
            for (int b = 0; b < 8; ++b) { const float s = sc[b * D + kp * 16 + k]; acc[b][0] += s * w[0]; acc[b][1] += s * w[1]; acc[b][2] += s * w[2]; acc[b][3] += s * w[3]; }
        }
#pragma unroll
        for (int b = 0; b < 8; ++b)
#pragma unroll
            for (int j = 0; j < 4; ++j) red[(kp * 8 + b) * 32 + n4 * 4 + j] = acc[b][j];
        __syncthreads();
        if (tid < 256) { const int b = tid >> 5, col = tid & 31; float s = 0.f;
            for (int k2 = 0; k2 < 64; ++k2) s += red[(k2 * 8 + b) * 32 + col];
            mod[(size_t)(l * 8 + b) * NMOD + cgp * 32 + col] = s + a.in[3][l * NMOD + cgp * 32 + col]; }
        __syncthreads();
    }
    LAS float* tile = (LAS float*)lds;
    if (MK_PRO_MASK & 2)
    for (int it = bid; it < DEPTH * 2944; it += G) {
        const int l = it / 2944; int r = it % 2944;
        const float* W; int K, N, kt, nt, kind = 0; size_t woff;
        if (r < 576) { W = a.in[5] + (size_t)l * D * INW; K = D; N = INW; kt = r / 36; nt = r % 36; woff = W_IN_OFF; }
        else if (r < 832) { r -= 576; W = a.in[12] + (size_t)l * D * D; K = D; N = D; kt = r / 16; nt = r % 16; woff = W_OUT_OFF; }
        else if (r < 2240) { r -= 832; W = a.in[14] + (size_t)l * D * GU; K = D; N = GU; kt = r / 88; nt = r % 88; woff = W_GU_OFF; kind = 1; }
        else { r -= 2240; W = a.in[15] + (size_t)l * FF * D; K = FF; N = D; kt = r / 16; nt = r % 16; woff = W_DN_OFF; }
        bf16_t* WT = (bf16_t*)(a.ws + WS_W + (size_t)l * W_LAYER + woff);
        const int n0 = nt * 64, k0 = kt * 64;
        int dn0 = n0;
        if (kind == 1) { dn0 = n0 < FF ? (n0 / 128) * 256 + (n0 % 128) : ((n0 - FF) / 128) * 256 + 128 + ((n0 - FF) % 128); }
#pragma unroll
        for (int p = 0; p < 2; ++p) { const int row = (tid >> 4) + 32 * p, c4 = tid & 15;
            const f32x4 v = *(const f32x4*)(W + (size_t)(k0 + row) * N + n0 + 4 * c4);
            tile[row * 65 + 4 * c4 + 0] = v[0]; tile[row * 65 + 4 * c4 + 1] = v[1]; tile[row * 65 + 4 * c4 + 2] = v[2]; tile[row * 65 + 4 * c4 + 3] = v[3]; }
        __syncthreads();
        { const int n = tid >> 3, kc = tid & 7; LAS const float* s = tile + (8 * kc) * 65 + n;
          u32x4 o; o.x = cvt_pk_bf16(s[0], s[65]); o.y = cvt_pk_bf16(s[2 * 65], s[3 * 65]); o.z = cvt_pk_bf16(s[4 * 65], s[5 * 65]); o.w = cvt_pk_bf16(s[6 * 65], s[7 * 65]);
          *(u32x4*)(WT + (size_t)(dn0 + n) * K + k0 + 8 * kc) = o; }
        __syncthreads();
    }
    if (MK_PRO_MASK & 4)
    { const float* ws_ = a.in[9]; bf16_t* wsb = (bf16_t*)(a.ws + WS_WSB);
      for (int i = bid * NTHREADS + tid; i < DEPTH * 4 * 128 * 128; i += G * NTHREADS) { const int s = i & 127, t = (i >> 7) & 127; const float v = (s <= t) ? ws_[i] : 0.f; wsb[i] = (bf16_t)(cvt_pk_bf16(v, 0.f) & 0xffffu); }
      const float* wp_ = a.in[6]; bf16_t* wpb = (bf16_t*)(a.ws + WS_WPB);
      for (int i = bid * NTHREADS + tid; i < DEPTH * 4 * 64 * 64; i += G * NTHREADS) { const int c = i & 63, e = (i >> 6) & 63, lg = i >> 12; wpb[i] = (bf16_t)(cvt_pk_bf16(wp_[(lg * 64 + c) * 64 + e], 0.f) & 0xffffu); } }
}

__device__ __forceinline__ void phase_norm(const float* xin, const float* g, const float* sh, const float* sc, bf16_t* hout) {
    const int tid = opaque_tid(), lane = tid & 63, wave = tid >> 6, gw = opaque_bid() * 8 + wave, NGW = gridDim.x * 8;
    const int b = gw & 7, r0 = gw >> 3, rstep = NGW >> 3;
    f32x4 gs[4], sv[4];
#pragma unroll
    for (int j = 0; j < 4; ++j) { const int col = 4 * lane + 256 * j; const f32x4 gg = *(const f32x4*)(g + col), ss = *(const f32x4*)(sc + (size_t)b * NMOD + col);
        gs[j] = gg * (ss + 1.0f); sv[j] = *(const f32x4*)(sh + (size_t)b * NMOD + col); }
    for (int r = r0; r < SEQ; r += rstep) {
        const size_t row = (size_t)b * SEQ + r; const f32x4* xr = (const f32x4*)(xin + row * D) + lane;
        f32x4 v[4]; float s = 0.f;
#pragma unroll
        for (int j = 0; j < 4; ++j) { v[j] = xr[64 * j]; s += (v[j][0] * v[j][0] + v[j][1] * v[j][1]) + (v[j][2] * v[j][2] + v[j][3] * v[j][3]); }
        const float rstd = __builtin_amdgcn_rsqf(wave_sum(s) * (1.0f / D) + EPS);
        u32x2* o = (u32x2*)(hout + row * D) + lane;
#pragma unroll
        for (int j = 0; j < 4; ++j) { const f32x4 y = v[j] * rstd * gs[j] + sv[j]; u32x2 w; w.x = cvt_pk_bf16(y[0], y[1]); w.y = cvt_pk_bf16(y[2], y[3]); o[64 * j] = w; }
    }
}
__device__ __forceinline__ void phase_final(const float* xin, const float* g, float* out) {
    const int tid = opaque_tid(), lane = tid & 63, wave = tid >> 6, gw = opaque_bid() * 8 + wave, NGW = gridDim.x * 8;
    f32x4 gs[4];
#pragma unroll
    for (int j = 0; j < 4; ++j) gs[j] = *(const f32x4*)(g + 4 * lane + 256 * j);
    for (int row = gw; row < M; row += NGW) {
        const f32x4* xr = (const f32x4*)(xin + (size_t)row * D) + lane; f32x4 v[4]; float s = 0.f;
#pragma unroll
        for (int j = 0; j < 4; ++j) { v[j] = xr[64 * j]; s += (v[j][0] * v[j][0] + v[j][1] * v[j][1]) + (v[j][2] * v[j][2] + v[j][3] * v[j][3]); }
        const float rstd = __builtin_amdgcn_rsqf(wave_sum(s) * (1.0f / D) + EPS);
        f32x4* o = (f32x4*)(out + (size_t)row * D) + lane;
#pragma unroll
        for (int j = 0; j < 4; ++j) o[64 * j] = v[j] * rstd * gs[j];
    }
}
__device__ __forceinline__ void attn_unit(int unit, const bf16_t* proj, bf16_t* merged, const float* mn, LAS unsigned char* lds, int wave, int lane) {
    const int b = unit >> 8, q0 = (unit & 255) * 32, n = lane & 31, h = lane >> 5, hd = wave;
    const size_t rowbase = (size_t)b * SEQ;
    constexpr float C1 = 0.125f * 1.4426950408889634f;
    bf16x8 bq[4];
    { const bf16_t* qp = proj + (rowbase + q0 + n) * INW + hd * 64 + 8 * h;
#pragma unroll
      for (int s = 0; s < 4; ++s) bq[s] = *(const bf16x8*)(qp + 16 * s); }
    f32x16 o0, o1;
#pragma unroll
    for (int i = 0; i < 16; ++i) { o0[i] = 0.f; o1[i] = 0.f; }
    float carry = 0.f;
    LAS unsigned char* kl = lds + wave * 9216; LAS unsigned char* vl = kl + 4608;
    const int nkt = min(17, (q0 >> 5) + 1);
    const int q4 = (lane & 15) >> 2, p4 = lane & 3, blk = (lane >> 4) & 1;
    for (int kt = 0; kt < nkt; ++kt) {
        const int k0 = q0 - 32 * kt;
        const bf16_t* kp = proj + (rowbase + k0) * INW + 512 + hd * 64;
        u32x4 kv[4], vv[4];
#pragma unroll
        for (int i = 0; i < 4; ++i) { const int c = lane + 64 * i, row = c >> 3, ch = c & 7; kv[i] = *(const u32x4*)(kp + (size_t)row * INW + ch * 8); vv[i] = *(const u32x4*)(kp + 512 + (size_t)row * INW + ch * 8); }
#pragma unroll
        for (int i = 0; i < 4; ++i) { const int c = lane + 64 * i, row = c >> 3, ch = c & 7; *(LAS u32x4*)(kl + row * 144 + ch * 16) = kv[i]; *(LAS u32x4*)(vl + row * 144 + ch * 16) = vv[i]; }
        asm volatile("s_waitcnt lgkmcnt(0)" ::: "memory");
        f32x16 st;
#pragma unroll
        for (int i = 0; i < 16; ++i) st[i] = 0.f;
#pragma unroll
        for (int s = 0; s < 4; ++s) { const bf16x8 ka = *(LAS const bf16x8*)(kl + n * 144 + (2 * s + h) * 16); st = MFMA32(ka, bq[s], st); }
        float y[16], lr[16], w[16];
#pragma unroll
        for (int i = 0; i < 16; ++i) {
            y[i] = st[i] * C1;
            const float sp = fmaxf(y[i], 0.f) + __builtin_amdgcn_logf(1.0f + __builtin_amdgcn_exp2f(-fabsf(y[i])));
            bool valid = true;
            if (kt == 0) valid = crow(i, h) < n;
            if (kt == 16) valid = crow(i, h) >= n;
            lr[i] = valid ? -sp : 0.f;
        }
        const float G0 = (lr[0] + lr[1]) + (lr[2] + lr[3]), G1 = (lr[4] + lr[5]) + (lr[6] + lr[7]), G2 = (lr[8] + lr[9]) + (lr[10] + lr[11]), G3 = (lr[12] + lr[13]) + (lr[14] + lr[15]);
        const float P0 = __shfl_xor(G0, 32), P1 = __shfl_xor(G1, 32), P2 = __shfl_xor(G2, 32), P3 = __shfl_xor(G3, 32);
        const float S2 = G3 + P3, S1 = S2 + (G2 + P2), S0 = S1 + (G1 + P1), tot = S0 + (G0 + P0);
        float T[4]; T[0] = S0 + (h == 0 ? P0 : 0.f); T[1] = S1 + (h == 0 ? P1 : 0.f); T[2] = S2 + (h == 0 ? P2 : 0.f); T[3] = (h == 0 ? P3 : 0.f);
#pragma unroll
        for (int g = 0; g < 4; ++g) {
            float later = carry + T[g];
#pragma unroll
            for (int j = 3; j >= 0; --j) { const int i = 4 * g + j;
                bool valid = true;
                if (kt == 0) valid = crow(i, h) < n;
                if (kt == 16) valid = crow(i, h) >= n;
                w[i] = valid ? __builtin_amdgcn_exp2f(lr[i] + y[i] + later) : 0.f;
                later += lr[i]; }
        }
        carry += tot;
        const bool done = __builtin_amdgcn_ballot_w64(carry >= -152.0f) == 0ull;
        bf16x8 wf[2];
#pragma unroll
        for (int s = 0; s < 2; ++s) { u32x4 p; p.x = cvt_pk_bf16(w[8 * s], w[8 * s + 1]); p.y = cvt_pk_bf16(w[8 * s + 2], w[8 * s + 3]); p.z = cvt_pk_bf16(w[8 * s + 4], w[8 * s + 5]); p.w = cvt_pk_bf16(w[8 * s + 6], w[8 * s + 7]); wf[s] = __builtin_bit_cast(bf16x8, p); }
#pragma unroll
        for (int s = 0; s < 2; ++s) {
            LAS const unsigned char* vb = vl + (16 * s + 4 * h + q4) * 144 + 32 * blk + 8 * p4;
            const s16x4 lo0 = vtr(vb), hi0 = vtr(vb + 8 * 144), lo1 = vtr(vb + 64), hi1 = vtr(vb + 8 * 144 + 64);
            o0 = MFMA32(cat8(lo0, hi0), wf[s], o0);
            o1 = MFMA32(cat8(lo1, hi1), wf[s], o1);
        }
        asm volatile("" ::: "memory");
        if (done) break;
    }
    float ss = 0.f;
#pragma unroll
    for (int i = 0; i < 16; ++i) ss += o0[i] * o0[i] + o1[i] * o1[i];
    ss += __shfl_xor(ss, 32);
    LAS float* ex = (LAS float*)(lds + 73728);
    if (h == 0) ex[wave * 32 + n] = ss;
    __syncthreads();
    float tot = 0.f;
#pragma unroll
    for (int w8 = 0; w8 < 8; ++w8) tot += ex[w8 * 32 + n];
    const float rstd = __builtin_amdgcn_rsqf(tot * (1.0f / 512.0f) + EPS);
    bf16_t* op = merged + (rowbase + q0 + n) * D + hd * 64 + 4 * h;
    const float* mp = mn + hd * 64 + 4 * h;
#pragma unroll
    for (int g = 0; g < 4; ++g) {
        const f32x4 m0 = *(const f32x4*)(mp + 8 * g), m1 = *(const f32x4*)(mp + 32 + 8 * g);
        u32x2 a0, a1;
        a0.x = cvt_pk_bf16(o0[4 * g] * rstd * m0[0], o0[4 * g + 1] * rstd * m0[1]); a0.y = cvt_pk_bf16(o0[4 * g + 2] * rstd * m0[2], o0[4 * g + 3] * rstd * m0[3]);
        a1.x = cvt_pk_bf16(o1[4 * g] * rstd * m1[0], o1[4 * g + 1] * rstd * m1[1]); a1.y = cvt_pk_bf16(o1[4 * g + 2] * rstd * m1[2], o1[4 * g + 3] * rstd * m1[3]);
        *(u32x2*)(op + 8 * g) = a0; *(u32x2*)(op + 32 + 8 * g) = a1;
    }
    __syncthreads();
}

__device__ __forceinline__ void sg_unit(int unit, const bf16_t* proj, bf16_t* merged, const float* mn, const float* sgn, const bf16_t* wsb, const float* bs, LAS unsigned char* lds, int tid, int wave, int lane) {
    const size_t R0 = (size_t)unit * 128;
    constexpr int RS = 528;
    { const int t = tid >> 2, part = tid & 3;
      const bf16_t* vp = proj + (R0 + t) * INW + 2048 + 64 * part;
      u32x4 raw[8];
#pragma unroll
      for (int i = 0; i < 8; ++i) raw[i] = *(const u32x4*)(vp + 8 * i);
      float s = 0.f;
#pragma unroll
      for (int i = 0; i < 8; ++i) s += (bflo(raw[i].x) + bfhi(raw[i].x)) + (bflo(raw[i].y) + bfhi(raw[i].y)) + (bflo(raw[i].z) + bfhi(raw[i].z)) + (bflo(raw[i].w) + bfhi(raw[i].w));
      s += __shfl_xor(s, 1); s += __shfl_xor(s, 2);
      const float mean = s * (1.0f / 256.0f);
      float q = 0.f;
#pragma unroll
      for (int i = 0; i < 8; ++i) { float d;
          d = bflo(raw[i].x) - mean; q += d * d; d = bfhi(raw[i].x) - mean; q += d * d; d = bflo(raw[i].y) - mean; q += d * d; d = bfhi(raw[i].y) - mean; q += d * d;
          d = bflo(raw[i].z) - mean; q += d * d; d = bfhi(raw[i].z) - mean; q += d * d; d = bflo(raw[i].w) - mean; q += d * d; d = bfhi(raw[i].w) - mean; q += d * d; }
      q += __shfl_xor(q, 1); q += __shfl_xor(q, 2);
      const float rstd = __builtin_amdgcn_rsqf(q * (1.0f / 256.0f) + EPS);
      const float* gp = sgn + 64 * part;
#pragma unroll
      for (int i = 0; i < 8; ++i) { const f32x4 ga = *(const f32x4*)(gp + 8 * i), gb = *(const f32x4*)(gp + 8 * i + 4); u32x4 o;
          o.x = cvt_pk_bf16((bflo(raw[i].x) - mean) * rstd * ga[0], (bfhi(raw[i].x) - mean) * rstd * ga[1]); o.y = cvt_pk_bf16((bflo(raw[i].y) - mean) * rstd * ga[2], (bfhi(raw[i].y) - mean) * rstd * ga[3]);
          o.z = cvt_pk_bf16((bflo(raw[i].z) - mean) * rstd * gb[0], (bfhi(raw[i].z) - mean) * rstd * gb[1]); o.w = cvt_pk_bf16((bflo(raw[i].w) - mean) * rstd * gb[2], (bfhi(raw[i].w) - mean) * rstd * gb[3]);
          *(LAS u32x4*)(lds + t * RS + 2 * (64 * part + 8 * i)) = o; }
    }
    __syncthreads();
    const int h4 = wave >> 1, dh = wave & 1, n = lane & 31, h = lane >> 5, cbase = 64 * h4 + 32 * dh;
    const int q4 = (lane & 15) >> 2, p4 = lane & 3, blk = (lane >> 4) & 1;
    f32x16 acc[4];
#pragma unroll
    for (int tt = 0; tt < 4; ++tt)
#pragma unroll
        for (int i = 0; i < 16; ++i) acc[tt][i] = 0.f;
#pragma unroll
    for (int ks = 0; ks < 8; ++ks) {
        LAS const unsigned char* vb = lds + (16 * ks + 8 * h + q4) * RS + 2 * (cbase + 16 * blk) + 8 * p4;
        const bf16x8 af = cat8(vtr(vb), vtr(vb + 4 * RS));
#pragma unroll
        for (int tt = 0; tt < 4; ++tt) if (ks < 2 * (tt + 1)) {
            const bf16x8 bfr = *(const bf16x8*)(wsb + (size_t)(h4 * 128 + 32 * tt + n) * 128 + 16 * ks + 8 * h);
            acc[tt] = MFMA32(af, bfr, acc[tt]); }
    }
    LAS float* ex = (LAS float*)(lds + 67584);
#pragma unroll
    for (int tt = 0; tt < 4; ++tt) { const int t = 32 * tt + n; const float bias = bs[h4 * 128 + t]; const bf16_t* up = proj + (R0 + t) * INW + 1792 + cbase + 4 * h; float s = 0.f;
#pragma unroll
        for (int g = 0; g < 4; ++g) { const u32x2 uu = *(const u32x2*)(up + 8 * g);
            const float v0 = bflo(uu.x) * (acc[tt][4 * g] + bias), v1 = bfhi(uu.x) * (acc[tt][4 * g + 1] + bias), v2 = bflo(uu.y) * (acc[tt][4 * g + 2] + bias), v3 = bfhi(uu.y) * (acc[tt][4 * g + 3] + bias);
            acc[tt][4 * g] = v0; acc[tt][4 * g + 1] = v1; acc[tt][4 * g + 2] = v2; acc[tt][4 * g + 3] = v3; s += (v0 * v0 + v1 * v1) + (v2 * v2 + v3 * v3); }
        s += __shfl_xor(s, 32);
        if (h == 0) ex[wave * 128 + t] = s; }
    __syncthreads();
#pragma unroll
    for (int tt = 0; tt < 4; ++tt) { const int t = 32 * tt + n; float tot = 0.f;
#pragma unroll
        for (int w8 = 0; w8 < 8; ++w8) tot += ex[w8 * 128 + t];
        const float rstd = __builtin_amdgcn_rsqf(tot * (1.0f / 256.0f) + EPS);
        bf16_t* op = merged + (R0 + t) * D + 768 + cbase + 4 * h; const float* mp = mn + 768 + cbase + 4 * h;
#pragma unroll
        for (int g = 0; g < 4; ++g) { const f32x4 m0 = *(const f32x4*)(mp + 8 * g); u32x2 a0;
            a0.x = cvt_pk_bf16(acc[tt][4 * g] * rstd * m0[0], acc[tt][4 * g + 1] * rstd * m0[1]); a0.y = cvt_pk_bf16(acc[tt][4 * g + 2] * rstd * m0[2], acc[tt][4 * g + 3] * rstd * m0[3]);
            *(u32x2*)(op + 8 * g) = a0; } }
    __syncthreads();
}

__device__ __forceinline__ void pool_unit(int unit, const bf16_t* proj, bf16_t* merged, const float* mn, const bf16_t* wpb, const float* pscale, LAS unsigned char* lds, int tid, int wave, int lane) {
    const size_t T0 = (size_t)unit * 128; const int pos0 = (unit & 63) * 128;
    constexpr int RS = 528;
    for (int c = tid; c < 144 * 32; c += NTHREADS) { const int li = c >> 5, ch = c & 31; u32x4 v = (u32x4){0u, 0u, 0u, 0u};
        if (li >= 16 || pos0 > 0) v = *(const u32x4*)(proj + (T0 + li - 16) * INW + 1536 + 8 * ch);
        *(LAS u32x4*)(lds + li * RS + 16 * ch) = v; }
    __syncthreads();
    const int g = wave >> 1, eh = wave & 1, n = lane & 31, h = lane >> 5, W = 2 << g;
    f32x16 acc[4];
#pragma unroll
    for (int tt = 0; tt < 4; ++tt)
#pragma unroll
        for (int i = 0; i < 16; ++i) acc[tt][i] = 0.f;
    bf16x8 af[4];
#pragma unroll
    for (int ks = 0; ks < 4; ++ks) af[ks] = *(const bf16x8*)(wpb + (size_t)(g * 64 + 32 * eh + n) * 64 + 16 * ks + 8 * h);
#pragma unroll
    for (int tt = 0; tt < 4; ++tt) {
        const int li = 16 + 32 * tt + n, pos = pos0 + 32 * tt + n; const float inv = 1.0f / (float)min(pos + 1, W);
#pragma unroll
        for (int ks = 0; ks < 4; ++ks) {
            LAS const unsigned char* pb = lds + li * RS + 2 * (64 * g + 16 * ks + 8 * h);
            float sm[8];
#pragma unroll
            for (int k = 0; k < 8; ++k) sm[k] = 0.f;
            for (int j = 0; j < W; ++j) { const u32x4 v = *(LAS const u32x4*)(pb - j * RS);
                sm[0] += bflo(v.x); sm[1] += bfhi(v.x); sm[2] += bflo(v.y); sm[3] += bfhi(v.y); sm[4] += bflo(v.z); sm[5] += bfhi(v.z); sm[6] += bflo(v.w); sm[7] += bfhi(v.w); }
            const u32x4 own = *(LAS const u32x4*)pb; u32x4 p;
            p.x = cvt_pk_bf16(sm[0] * inv - bflo(own.x), sm[1] * inv - bfhi(own.x)); p.y = cvt_pk_bf16(sm[2] * inv - bflo(own.y), sm[3] * inv - bfhi(own.y));
            p.z = cvt_pk_bf16(sm[4] * inv - bflo(own.z), sm[5] * inv - bfhi(own.z)); p.w = cvt_pk_bf16(sm[6] * inv - bflo(own.w), sm[7] * inv - bfhi(own.w));
            acc[tt] = MFMA32(af[ks], __builtin_bit_cast(bf16x8, p), acc[tt]);
        }
    }
    LAS float* ex = (LAS float*)(lds + 76032);
    const int ebase = 64 * g + 32 * eh + 4 * h;
#pragma unroll
    for (int tt = 0; tt < 4; ++tt) { float s = 0.f;
#pragma unroll
        for (int gg = 0; gg < 4; ++gg) { const f32x4 ps = *(const f32x4*)(pscale + ebase + 8 * gg);
#pragma unroll
            for (int j = 0; j < 4; ++j) { const float v = acc[tt][4 * gg + j] * ps[j]; acc[tt][4 * gg + j] = v; s += v * v; } }
        s += __shfl_xor(s, 32);
        if (h == 0) ex[wave * 128 + 32 * tt + n] = s; }
    __syncthreads();
#pragma unroll
    for (int tt = 0; tt < 4; ++tt) { const int t = 32 * tt + n; float tot = 0.f;
#pragma unroll
        for (int w8 = 0; w8 < 8; ++w8) tot += ex[w8 * 128 + t];
        const float rstd = __builtin_amdgcn_rsqf(tot * (1.0f / 256.0f) + EPS);
        bf16_t* op = merged + (T0 + t) * D + 512 + ebase; const float* mp = mn + 512 + ebase;
#pragma unroll
        for (int gg = 0; gg < 4; ++gg) { const f32x4 m0 = *(const f32x4*)(mp + 8 * gg); u32x2 a0;
            a0.x = cvt_pk_bf16(acc[tt][4 * gg] * rstd * m0[0], acc[tt][4 * gg + 1] * rstd * m0[1]); a0.y = cvt_pk_bf16(acc[tt][4 * gg + 2] * rstd * m0[2], acc[tt][4 * gg + 3] * rstd * m0[3]);
            *(u32x2*)(op + 8 * gg) = a0; } }
    __syncthreads();
}

__device__ __forceinline__ void phase_mix(const Args& a, int l, LAS unsigned char* lds) {
    const int tid = opaque_tid(), lane = tid & 63, wave = __builtin_amdgcn_readfirstlane(tid >> 6), G = gridDim.x, bid = opaque_bid();
    const bf16_t* proj = (const bf16_t*)(a.ws + WS_P); bf16_t* merged = (bf16_t*)(a.ws + WS_H);
    const float* mn = a.in[11] + (size_t)l * D;
    for (int u = bid; u < M / 32; u += G) attn_unit(u, proj, merged, mn, lds, wave, lane);
    { const float* sgn = a.in[8] + l * 256; const bf16_t* wsb = (const bf16_t*)(a.ws + WS_WSB) + (size_t)l * 4 * 128 * 128; const float* bs = a.in[10] + l * 4 * 128;
      for (int u = bid; u < M / 128; u += G) sg_unit(u, proj, merged, mn, sgn, wsb, bs, lds, tid, wave, lane); }
    { const bf16_t* wpb = (const bf16_t*)(a.ws + WS_WPB) + (size_t)l * 4 * 64 * 64; const float* pscale = a.in[7] + l * 256;
      for (int u = bid; u < M / 128; u += G) pool_unit(u, proj, merged, mn, wpb, pscale, lds, tid, wave, lane); }
}
constexpr int N_STEPS = 2 + 7 * DEPTH;
__global__ void __launch_bounds__(NTHREADS, 2) fwd(Args args) {
    extern __shared__ __attribute__((aligned(16))) unsigned char lds_raw[];
    LAS unsigned char* lds = (LAS unsigned char*)lds_raw;
#if MK_ONE_LAUNCH
#define SEAM() grid_bar(bar_ctr, bar_target)
#define SEAM_CG() do { __syncthreads(); cg::this_grid().sync(); } while (0)
#else
#define SEAM() do { } while (0)
#define SEAM_CG() do { } while (0)
#endif
#define RUN(k) (args.ph_lo <= (k) && (k) < args.ph_hi && (k) < MK_MAX_STEP)
    unsigned char* ws = args.ws;
    const float* mod = (const float*)(ws + WS_MOD);
    bf16_t* hbuf = (bf16_t*)(ws + WS_H); bf16_t* pbuf = (bf16_t*)(ws + WS_P);
    unsigned* bar_ctr = (unsigned*)(ws + WS_BAR); unsigned bar_target = 0u; (void)bar_ctr; (void)bar_target;
    if (RUN(0)) phase_pro(args, lds);
    SEAM_CG();
#pragma nounroll
    for (int l = 0; l < DEPTH; ++l) {
        const int s0 = 1 + 7 * l;
        const float* xin = (l == 0) ? args.in[0] : args.out;
        const float* modl = mod + (size_t)l * 8 * NMOD;
        const unsigned char* wl = ws + WS_W + (size_t)l * W_LAYER;
        if (RUN(s0 + 0)) phase_norm(xin, args.in[4] + l * D, modl, modl + 1024, hbuf);
        SEAM();
        if (RUN(s0 + 1)) { pg8::Gemm g{hbuf, (const bf16_t*)(wl + W_IN_OFF), M, INW, D}; pg8::StaticOrder S; S.init(M, INW, gridDim.x, opaque_bid()); pg8::EpiProj E{pbuf};
            pg8::gemm_phase<pg8::EpiProj, pg8::StaticOrder, true, true>(lds, g, S, E); }
        SEAM();
        if (RUN(s0 + 2)) phase_mix(args, l, lds);
        SEAM();
        if (RUN(s0 + 3)) { pg8::Gemm g{hbuf, (const bf16_t*)(wl + W_OUT_OFF), M, D, D}; pg8::StaticOrder S; S.init(M, D, gridDim.x, opaque_bid()); pg8::EpiRes E{xin, args.out, modl + 2048};
            pg8::gemm_phase<pg8::EpiRes, pg8::StaticOrder, true, true>(lds, g, S, E); }
        SEAM();
        if (RUN(s0 + 4)) phase_norm(args.out, args.in[13] + l * D, modl + 3072, modl + 4096, hbuf);
        SEAM();
        if (RUN(s0 + 5)) { pg8::Gemm g{hbuf, (const bf16_t*)(wl + W_GU_OFF), M, GU, D}; pg8::StaticOrder S; S.init(M, GU, gridDim.x, opaque_bid()); pg8::EpiSwiglu E{pbuf};
            pg8::gemm_phase<pg8::EpiSwiglu, pg8::StaticOrder, true, true>(lds, g, S, E); }
        SEAM();
        if (RUN(s0 + 6)) { pg8::Gemm g{pbuf, (const bf16_t*)(wl + W_DN_OFF), M, D, FF}; pg8::StaticOrder S; S.init(M, D, gridDim.x, opaque_bid()); pg8::EpiRes E{args.out, args.out, modl + 5120};
            pg8::gemm_phase<pg8::EpiRes, pg8::StaticOrder, true, true>(lds, g, S, E); }
        SEAM();
    }
    if (RUN(N_STEPS - 1)) phase_final(args.out, args.in[16], args.out);
#undef RUN
#undef SEAM
#undef SEAM_CG
}

extern "C" void kernel_launch(void* const* d_in, const int* in_sizes, int n_in, void* d_out, int out_size, void* d_ws, size_t ws_size, hipStream_t stream) {
    static int grid = 0;
    if (grid == 0) {
        if (n_in != 17 || in_sizes[0] != M * D || out_size != M * D || ws_size < WS_END + 256) { fprintf(stderr, "kernel_launch: unexpected shapes (n_in %d in0 %d out %d ws %zu)\n", n_in, n_in > 0 ? in_sizes[0] : -1, out_size, ws_size); grid = -1; return; }
        int dev = 0, cus = 0, per_cu = 0;
        if (hipGetDevice(&dev) != hipSuccess || hipDeviceGetAttribute(&cus, hipDeviceAttributeMultiprocessorCount, dev) != hipSuccess) { grid = -1; return; }
        if (hipFuncSetAttribute((const void*)fwd, hipFuncAttributeMaxDynamicSharedMemorySize, LDS_BYTES) != hipSuccess) { fprintf(stderr, "kernel_launch: hipFuncSetAttribute failed\n"); grid = -1; return; }
        if (hipOccupancyMaxActiveBlocksPerMultiprocessor(&per_cu, (const void*)fwd, NTHREADS, LDS_BYTES) != hipSuccess || per_cu < 1) { fprintf(stderr, "kernel_launch: occupancy query gave %d\n", per_cu); per_cu = 1; }
        (void)hipGetLastError();
        grid = cus * per_cu;
    }
    if (grid < 0) return;
    Args a{};
    for (int i = 0; i < 17; ++i) a.in[i] = (const float*)d_in[i];
    a.out = (float*)d_out; a.ws = (unsigned char*)d_ws;
#if MK_ONE_LAUNCH
    if (hipMemsetAsync((char*)d_ws + WS_BAR, 0, 256, stream) != hipSuccess) { fprintf(stderr, "kernel_launch: memset failed\n"); return; }
    a.ph_lo = 0; a.ph_hi = N_STEPS;
    void* params[] = {&a};
    hipError_t e = hipLaunchCooperativeKernel((const void*)fwd, dim3(grid), dim3(NTHREADS), params, LDS_BYTES, stream);
    if (e != hipSuccess) fprintf(stderr, "cooperative launch failed: %s (grid %d)\n", hipGetErrorString(e), grid);
#else
    for (int k = 0; k < N_STEPS && k < (MK_MAX_STEP > 0 ? MK_MAX_STEP : 1); ++k) { a.ph_lo = k; a.ph_hi = k + 1; hipLaunchKernelGGL(fwd, dim3(grid), dim3(NTHREADS), LDS_BYTES, stream, a); }
#endif
}
```

```cpp
#include <hip/hip_runtime.h>
#include <hip/hip_cooperative_groups.h>
#include <cstdio>
#include <cstdint>
namespace cg = cooperative_groups;
#ifndef MK_MAX_STEP
#define MK_MAX_STEP 100
#define MK_PRO_MASK 7
#endif
#ifndef MK_ONE_LAUNCH
#define MK_ONE_LAUNCH 1
#endif
__device__ __forceinline__ int opaque_tid() { int t = threadIdx.x; asm volatile("" : "+v"(t)); return t; }
__device__ __forceinline__ int opaque_bid() { int b = blockIdx.x; asm volatile("" : "+s"(b)); return b; }
namespace pg8 {
#define PG8_LAS __attribute__((address_space(3)))
typedef unsigned short bf16_t;
typedef short bf16x8 __attribute__((ext_vector_type(8)));
typedef float f32x4 __attribute__((ext_vector_type(4)));
typedef unsigned u32x4 __attribute__((ext_vector_type(4)));
constexpr int BM = 256, BK = 64, HALF = 128, HTB = HALF * BK * 2  , STAGE_BYTES = 8 * HTB, NXCD = 8, WGM = 8;

__host__ __device__ __forceinline__ int lds_byte(int r, int c) { const int st = (r >> 4) * 2 + (c >> 5), rr = r & 15, cc = c & 31, ob = rr * 64 + cc * 2; return st * 1024 + (ob ^ (((ob >> 9) & 1) << 5)); }
__host__ __device__ __forceinline__ void stage_rc(int b, int& R, int& C) { const int st = b / 1024, sb = b % 1024, swz = sb ^ (((sb >> 9) & 1) << 5); R = (st >> 1) * 16 + swz / 64; C = (st & 1) * 32 + (swz % 64) / 2; }
__host__ __device__ __forceinline__ int perm32(int rho) { const int n = rho >> 4, i = rho & 15; return 8 * (i >> 2) + 4 * n + (i & 3); }

struct Unit { int pm, pn; };
struct Gemm { const bf16_t* A; const bf16_t* Bt; int M, N, K; };

struct StaticOrder {
    int nM, nN, nwg, G, c;
    __host__ __device__ void init(int M, int N, int G_, int c_) { nM = M / BM; nN = N / BM; nwg = nM * nN; G = G_; c = c_; }
    __host__ __device__ bool next(int i, Unit& u) const {
        const long L = (long)i * G + c; if (L >= nwg) return false;
        int wgid = (int)L; { const int q = nwg / NXCD, r = nwg % NXCD, xcd = wgid % NXCD, off = wgid / NXCD; wgid = (xcd < r ? xcd * (q + 1) : r * (q + 1) + (xcd - r) * q) + off; }
        const int nig = WGM * nN, gid = wgid / nig, fm = gid * WGM, gsz = (nM - fm) < WGM ? (nM - fm) : WGM;
        u.pm = fm + ((wgid % nig) % gsz); u.pn = (wgid % nig) / gsz; return true;
    }
    __device__ __forceinline__ void a_ready(const Unit&) const {}
    __device__ __forceinline__ void done(const Unit&) const {}
};

typedef unsigned u32x2 __attribute__((ext_vector_type(2)));
typedef float f32x2 __attribute__((ext_vector_type(2)));
typedef __bf16 bf16x2_t __attribute__((ext_vector_type(2)));
__device__ __forceinline__ unsigned cvt_pk_bf16(float lo, float hi) { f32x2 v = {lo, hi}; bf16x2_t b = __builtin_convertvector(v, bf16x2_t); return __builtin_bit_cast(unsigned, b); }
__device__ __forceinline__ float fast_sigmoid(float x) { return __builtin_amdgcn_rcpf(1.0f + __builtin_amdgcn_exp2f(-1.4426950408889634f * x)); }
__device__ __forceinline__ float gelu_tanh(float x) { const float u = 0.7978845608028654f * (x + 0.044715f * x * x * x); return x * fast_sigmoid(2.0f * u); }
__device__ __forceinline__ float silu_f(float x) { return x * fast_sigmoid(x); }

struct EpiProj {
    static constexpr bool PERM = true, AFTER_DRAIN = false;
    bf16_t* O; const float* rowsq; const float* shw;
    __device__ __forceinline__ void operator()(const f32x4 (&acc)[2][2][4][2], const Unit& u, int wr, int wc, int fr, int fq) const {
        const int row0 = u.pm * BM + wr * 64 + fr, col0 = u.pn * BM + wc * 32 + 8 * fq; const bool act = u.pn >= 7;
        f32x4 bv[2][2];
#pragma unroll
        for (int bj = 0; bj < 2; ++bj)
#pragma unroll
            for (int n = 0; n < 2; ++n) bv[bj][n] = rowsq ? *(const f32x4*)(shw + (size_t)(u.pm >> 5) * 2304 + col0 + bj * HALF + 4 * n) : (f32x4){0.f, 0.f, 0.f, 0.f};
        float rsv[2][4];
#pragma unroll
        for (int ai = 0; ai < 2; ++ai)
#pragma unroll
            for (int m = 0; m < 4; ++m) rsv[ai][m] = rowsq ? rowsq[row0 + ai * HALF + m * 16] : 0.f;
#pragma unroll
        for (int ai = 0; ai < 2; ++ai)
#pragma unroll
            for (int m = 0; m < 4; ++m) { bf16_t* rowp = O + (size_t)(row0 + ai * HALF + m * 16) * 2304 + col0;
                const float rs = rowsq ? __builtin_amdgcn_rsqf(rsv[ai][m] * (1.0f / 1024.0f) + 1e-6f) : 1.0f;
#pragma unroll
                for (int bj = 0; bj < 2; ++bj) { f32x4 v0 = acc[ai][bj][m][0] * rs + bv[bj][0], v1 = acc[ai][bj][m][1] * rs + bv[bj][1];
                    if (act) { v0 = (f32x4){gelu_tanh(v0[0]), gelu_tanh(v0[1]), gelu_tanh(v0[2]), gelu_tanh(v0[3])}; v1 = (f32x4){gelu_tanh(v1[0]), gelu_tanh(v1[1]), gelu_tanh(v1[2]), gelu_tanh(v1[3])}; }
                    u32x4 w; w.x = cvt_pk_bf16(v0[0], v0[1]); w.y = cvt_pk_bf16(v0[2], v0[3]); w.z = cvt_pk_bf16(v1[0], v1[1]); w.w = cvt_pk_bf16(v1[2], v1[3]);
                    *(u32x4*)(rowp + bj * HALF) = w; } }
    }
};
struct EpiSwiglu {
    static constexpr bool PERM = true, AFTER_DRAIN = false;
    bf16_t* O; const float* rowsq; const float* shw;
    __device__ __forceinline__ void operator()(const f32x4 (&acc)[2][2][4][2], const Unit& u, int wr, int wc, int fr, int fq) const {
        const int row0 = u.pm * BM + wr * 64 + fr, col0 = u.pn * HALF + wc * 32 + 8 * fq;
        const float* sp = shw + (size_t)(u.pm >> 5) * 5632 + u.pn * BM + wc * 32 + 8 * fq;
        const f32x4 bg0 = *(const f32x4*)(sp), bg1 = *(const f32x4*)(sp + 4), bu0 = *(const f32x4*)(sp + HALF), bu1 = *(const f32x4*)(sp + HALF + 4);
        float rsv[2][4];
#pragma unroll
        for (int ai = 0; ai < 2; ++ai)
#pragma unroll
            for (int m = 0; m < 4; ++m) rsv[ai][m] = rowsq[row0 + ai * HALF + m * 16];
#pragma unroll
        for (int ai = 0; ai < 2; ++ai)
#pragma unroll
            for (int m = 0; m < 4; ++m) { bf16_t* rowp = O + (size_t)(row0 + ai * HALF + m * 16) * 2816 + col0;
                const float rs = __builtin_amdgcn_rsqf(rsv[ai][m] * (1.0f / 1024.0f) + 1e-6f);
                const f32x4 g0 = acc[ai][0][m][0] * rs + bg0, g1 = acc[ai][0][m][1] * rs + bg1, u0 = acc[ai][1][m][0] * rs + bu0, u1 = acc[ai][1][m][1] * rs + bu1;
                u32x4 w; w.x = cvt_pk_bf16(silu_f(g0[0]) * u0[0], silu_f(g0[1]) * u0[1]); w.y = cvt_pk_bf16(silu_f(g0[2]) * u0[2], silu_f(g0[3]) * u0[3]);
                w.z = cvt_pk_bf16(silu_f(g1[0]) * u1[0], silu_f(g1[1]) * u1[1]); w.w = cvt_pk_bf16(silu_f(g1[2]) * u1[2], silu_f(g1[3]) * u1[3]);
                *(u32x4*)rowp = w; }
    }
};
struct EpiRes {
    static constexpr bool PERM = false, AFTER_DRAIN = false;
    const float* xin; float* xout; const float* gate;
    bf16_t* xs; float* rowsq; const float* gn; const float* scn;
    __device__ __forceinline__ void operator()(const f32x4 (&acc)[2][2][4][2], const Unit& u, int wr, int wc, int fr, int fq) const {
        const int col0 = u.pn * BM + wc * 32 + 4 * fq; const float* gp = gate + (size_t)(u.pm >> 5) * 6144 + col0;
        f32x4 gv[2][2], gs[2][2];
#pragma unroll
        for (int bj = 0; bj < 2; ++bj)
#pragma unroll
            for (int n = 0; n < 2; ++n) { gv[bj][n] = *(const f32x4*)(gp + bj * HALF + n * 16);
                gs[bj][n] = xs ? *(const f32x4*)(gn + col0 + bj * HALF + n * 16) * (*(const f32x4*)(scn + (size_t)(u.pm >> 5) * 6144 + col0 + bj * HALF + n * 16) + 1.0f) : (f32x4){0.f, 0.f, 0.f, 0.f}; }
        const size_t base = (size_t)(u.pm * BM + wr * 64 + fr) * 1024 + col0;
        f32x4 xb[3][4];
#define EPIRES_LOAD(G) do { _Pragma("unroll") for (int bj_ = 0; bj_ < 2; ++bj_) _Pragma("unroll") for (int n_ = 0; n_ < 2; ++n_) \
            xb[(G) % 3][bj_ * 2 + n_] = *(const f32x4*)(xin + base + (size_t)(((G) >> 2) * HALF + ((G) & 3) * 16) * 1024 + bj_ * HALF + n_ * 16); } while (0)
        EPIRES_LOAD(0); EPIRES_LOAD(1);
#pragma unroll
        for (int g = 0; g < 8; ++g) { const int ai = g >> 2, m = g & 3;
            if (g + 2 < 8) EPIRES_LOAD(g + 2);
            { const int row = u.pm * BM + ai * HALF + wr * 64 + m * 16 + fr; const size_t off = (size_t)row * 1024 + col0; float ssq = 0.f;
#pragma unroll
                for (int bj = 0; bj < 2; ++bj)
#pragma unroll
                    for (int n = 0; n < 2; ++n) { const f32x4 xv = xb[g % 3][bj * 2 + n];
                        const f32x4 o = xv + gv[bj][n] * acc[ai][bj][m][n];
                        *(f32x4*)(xout + off + bj * HALF + n * 16) = o;
                        if (xs) { ssq += (o[0] * o[0] + o[1] * o[1]) + (o[2] * o[2] + o[3] * o[3]); const f32x4 y = o * gs[bj][n];
                            u32x2 w; w.x = cvt_pk_bf16(y[0], y[1]); w.y = cvt_pk_bf16(y[2], y[3]); *(u32x2*)(xs + off + bj * HALF + n * 16) = w; } }
                if (xs) { ssq += __shfl_xor(ssq, 16); ssq += __shfl_xor(ssq, 32);
                    if (fq == 0) __hip_atomic_fetch_add(rowsq + row, ssq, __ATOMIC_RELAXED, __HIP_MEMORY_SCOPE_AGENT); } } }
#undef EPIRES_LOAD
    }
};
template <class Epi, class Sched, bool ALIGN_EPI = false, bool SP2 = false>
__device__ __forceinline__ void gemm_phase(PG8_LAS unsigned char* lds, const Gemm g, const Sched& S, const Epi& E) {
    const int tid = opaque_tid(), wid = __builtin_amdgcn_readfirstlane(tid >> 6), lane = tid & 63, wr = wid >> 2, wc = wid & 3, fr = lane & 15, fq = lane >> 4;
    const int K = g.K, nt = K / BK;
    unsigned voffA[2], voffB[2];
#pragma unroll
    for (int i = 0; i < 2; ++i) { int R, C; stage_rc(tid * 16 + i * 8192, R, C); const int Rb = Epi::PERM ? ((R & ~31) + perm32(R & 31)) : R;
        voffA[i] = (unsigned)(R * K + C) * 2u; voffB[i] = (unsigned)(Rb * K + C) * 2u; }
    const size_t kstep = (size_t)(BK * 2);
    const size_t hstep = (size_t)HALF * K * 2;
    const size_t tstep = 2 * hstep;
    const unsigned ldsw = (unsigned)wid * 1024u;
    const int aoff = lds_byte(wr * 64 + fr, fq * 8), boff = lds_byte(wc * 32 + fr, fq * 8);
#define PG8_SA(b, h) (((b) * 2 + (h)) * HTB)
#define PG8_SB(b, h) ((4 + (b) * 2 + (h)) * HTB)
#define PG8_STAGE(bufoff, gbase, voff) do { _Pragma("unroll") for (int _i = 0; _i < 2; ++_i) \
        __builtin_amdgcn_global_load_lds((const unsigned*)((const char*)(gbase) + (voff)[_i]), (PG8_LAS unsigned*)(lds + (bufoff) + ldsw + _i * 8192), 16, 0, 0); } while (0)
#define PG8_LDA(dst, b, h) do { _Pragma("unroll") for (int m = 0; m < 4; ++m) _Pragma("unroll") for (int k = 0; k < 2; ++k) dst[m][k] = *(const PG8_LAS bf16x8*)(lds + PG8_SA(b, h) + aoff + m * 2048 + k * 1024); } while (0)
#define PG8_LDB(dst, b, h) do { _Pragma("unroll") for (int n = 0; n < 2; ++n) _Pragma("unroll") for (int k = 0; k < 2; ++k) dst[n][k] = *(const PG8_LAS bf16x8*)(lds + PG8_SB(b, h) + boff + n * 2048 + k * 1024); } while (0)
#define PG8_MMA(ai, bj, At, Bt) do { __builtin_amdgcn_s_setprio(1); _Pragma("unroll") for (int m = 0; m < 4; ++m) _Pragma("unroll") for (int n = 0; n < 2; ++n) _Pragma("unroll") for (int k = 0; k < 2; ++k) \
        acc[ai][bj][m][n] = __builtin_amdgcn_mfma_f32_16x16x32_bf16(Bt[n][k], At[m][k], acc[ai][bj][m][n], 0, 0, 0); __builtin_amdgcn_s_setprio(0); } while (0)
#define PG8_WAIT_V(n) asm volatile("s_waitcnt vmcnt(" #n ")" ::: "memory")
#define PG8_WAIT_L(n) asm volatile("s_waitcnt lgkmcnt(" #n ")" ::: "memory")
#define PG8_BAR __builtin_amdgcn_s_barrier()
#define PG8_SCHED __builtin_amdgcn_sched_barrier(0)
    Unit cur, nxt; int ui = 0;
    if (!S.next(0, cur)) return;
    f32x4 acc[2][2][4][2];
#pragma unroll
    for (int a = 0; a < 2; ++a)
#pragma unroll
        for (int b = 0; b < 2; ++b)
#pragma unroll
            for (int m = 0; m < 4; ++m)
#pragma unroll
                for (int n = 0; n < 2; ++n) acc[a][b][m][n] = (f32x4){0.f, 0.f, 0.f, 0.f};
    bf16x8 At[4][2], B0[2][2], B1[2][2];
    const char* cA = (const char*)g.A + (size_t)cur.pm * tstep; const char* cB = (const char*)g.Bt + (size_t)cur.pn * tstep;
    S.a_ready(cur);
    if constexpr (SP2) {
        PG8_STAGE(PG8_SB(0, 0), cB, voffB); PG8_STAGE(PG8_SB(0, 1), cB + hstep, voffB); PG8_STAGE(PG8_SA(0, 0), cA, voffA); PG8_STAGE(PG8_SA(0, 1), cA + hstep, voffA);
        if (wr == 1) PG8_BAR;
        PG8_WAIT_V(2); PG8_BAR;
        PG8_STAGE(PG8_SB(1, 0), cB + kstep, voffB); PG8_STAGE(PG8_SA(1, 0), cA + kstep, voffA); PG8_STAGE(PG8_SB(1, 1), cB + hstep + kstep, voffB);
        PG8_WAIT_V(6); PG8_BAR;
    } else {
        PG8_STAGE(PG8_SB(0, 0), cB, voffB); PG8_STAGE(PG8_SA(0, 0), cA, voffA); PG8_STAGE(PG8_SB(0, 1), cB + hstep, voffB); PG8_STAGE(PG8_SA(0, 1), cA + hstep, voffA);
        if (wr == 1) PG8_BAR;
        PG8_WAIT_V(4); PG8_BAR;
        PG8_STAGE(PG8_SB(1, 0), cB + kstep, voffB); PG8_STAGE(PG8_SA(1, 0), cA + kstep, voffA); PG8_STAGE(PG8_SB(1, 1), cB + hstep + kstep, voffB);
        PG8_WAIT_V(6); PG8_BAR;
    }
    for (;;) {
        const bool has_next = S.next(ui + 1, nxt);
        const char* nA = has_next ? (const char*)g.A + (size_t)nxt.pm * tstep : cA; const char* nB = has_next ? (const char*)g.Bt + (size_t)nxt.pn * tstep : cB;
        for (int t = 0; t < nt; t += 2) {
            const bool last = (t == nt - 2);
            const char* a1 = cA + (size_t)(t + 1) * kstep;
            const char* a2 = last ? nA : cA + (size_t)(t + 2) * kstep; const char* b2 = last ? nB : cB + (size_t)(t + 2) * kstep;
            const char* a3 = a2 + kstep; const char* b3 = b2 + kstep;
            if (last && has_next) S.a_ready(nxt);
            if constexpr (SP2) {
            PG8_LDB(B0, 0, 0); PG8_LDB(B1, 0, 1); PG8_SCHED; PG8_LDA(At, 0, 0); PG8_STAGE(PG8_SA(1, 1), a1 + hstep, voffA);
            PG8_WAIT_V(8); PG8_WAIT_L(0); PG8_BAR; PG8_MMA(0, 0, At, B0); PG8_MMA(0, 1, At, B1); PG8_BAR; PG8_SCHED;
            PG8_LDA(At, 0, 1); PG8_STAGE(PG8_SB(0, 0), b2, voffB); PG8_STAGE(PG8_SB(0, 1), b2 + hstep, voffB); PG8_STAGE(PG8_SA(0, 0), a2, voffA);
            PG8_WAIT_V(8); PG8_WAIT_L(0); PG8_BAR; PG8_MMA(1, 0, At, B0); PG8_MMA(1, 1, At, B1); PG8_BAR; PG8_SCHED;
            PG8_LDB(B0, 1, 0); PG8_LDB(B1, 1, 1); PG8_SCHED; PG8_LDA(At, 1, 0); PG8_STAGE(PG8_SA(0, 1), a2 + hstep, voffA);
            PG8_WAIT_V(8); PG8_WAIT_L(0); PG8_BAR; PG8_MMA(0, 0, At, B0); PG8_MMA(0, 1, At, B1); PG8_BAR; PG8_SCHED;
            PG8_LDA(At, 1, 1); PG8_STAGE(PG8_SB(1, 0), b3, voffB); PG8_STAGE(PG8_SB(1, 1), b3 + hstep, voffB); PG8_STAGE(PG8_SA(1, 0), a3, voffA);
            PG8_WAIT_V(8); PG8_WAIT_L(0); PG8_BAR; PG8_MMA(1, 0, At, B0); PG8_MMA(1, 1, At, B1); PG8_BAR; PG8_SCHED;
            } else {
            PG8_LDB(B0, 0, 0); PG8_SCHED; PG8_LDA(At, 0, 0); PG8_STAGE(PG8_SA(1, 1), a1 + hstep, voffA);
            PG8_WAIT_L(8); PG8_BAR; PG8_WAIT_L(0); PG8_MMA(0, 0, At, B0); PG8_BAR; PG8_SCHED;
            PG8_LDB(B1, 0, 1); PG8_STAGE(PG8_SB(0, 0), b2, voffB);
            PG8_BAR; PG8_WAIT_L(0); PG8_MMA(0, 1, At, B1); PG8_BAR;
            PG8_LDA(At, 0, 1); PG8_STAGE(PG8_SA(0, 0), a2, voffA);
            PG8_BAR; PG8_WAIT_L(0); PG8_MMA(1, 0, At, B0); PG8_BAR; PG8_SCHED;
            PG8_STAGE(PG8_SB(0, 1), b2 + hstep, voffB);
            PG8_WAIT_V(6); PG8_BAR; PG8_MMA(1, 1, At, B1); PG8_BAR;
            PG8_LDB(B0, 1, 0); PG8_SCHED; PG8_LDA(At, 1, 0); PG8_STAGE(PG8_SA(0, 1), a2 + hstep, voffA);
            PG8_WAIT_L(8); PG8_BAR; PG8_WAIT_L(0); PG8_MMA(0, 0, At, B0); PG8_BAR; PG8_SCHED;
            PG8_LDB(B1, 1, 1); PG8_STAGE(PG8_SB(1, 0), b3, voffB);
            PG8_BAR; PG8_WAIT_L(0); PG8_MMA(0, 1, At, B1); PG8_BAR;
            PG8_LDA(At, 1, 1); PG8_STAGE(PG8_SA(1, 0), a3, voffA);
            PG8_BAR; PG8_WAIT_L(0); PG8_MMA(1, 0, At, B0); PG8_BAR; PG8_SCHED;
            PG8_STAGE(PG8_SB(1, 1), b3 + hstep, voffB);
            PG8_WAIT_V(6); PG8_BAR; PG8_MMA(1, 1, At, B1); PG8_BAR;
            }
        }
        if constexpr (ALIGN_EPI) { if (wr == 0) PG8_BAR; }
        if constexpr (!Epi::AFTER_DRAIN) { E(acc, cur, wr, wc, fr, fq); S.done(cur); }
        if (!has_next) break;
#pragma unroll
        for (int a = 0; a < 2; ++a)
#pragma unroll
            for (int b = 0; b < 2; ++b)
#pragma unroll
                for (int m = 0; m < 4; ++m)
#pragma unroll
                    for (int n = 0; n < 2; ++n) acc[a][b][m][n] = (f32x4){0.f, 0.f, 0.f, 0.f};
        cur = nxt; cA = nA; cB = nB; ++ui;
        if constexpr (ALIGN_EPI) { if (wr == 1) PG8_BAR; }
    }
    PG8_WAIT_V(0);
    if constexpr (!ALIGN_EPI) { if (wr == 0) PG8_BAR; }
    PG8_BAR;
    if constexpr (Epi::AFTER_DRAIN) { E.fused(acc, cur, wr, wc, fr, fq, lds, wid, lane); S.done(cur); }
#undef PG8_SA
#undef PG8_SB
#undef PG8_STAGE
#undef PG8_LDA
#undef PG8_LDB
#undef PG8_MMA
#undef PG8_WAIT_V
#undef PG8_WAIT_L
#undef PG8_BAR
#undef PG8_SCHED
}
}
#define LAS __attribute__((address_space(3)))
typedef unsigned short bf16_t;
typedef short bf16x8 __attribute__((ext_vector_type(8)));
typedef short s16x4 __attribute__((ext_vector_type(4)));
typedef float f32x4 __attribute__((ext_vector_type(4)));
typedef float f32x16 __attribute__((ext_vector_type(16)));
typedef unsigned u32x4 __attribute__((ext_vector_type(4)));
typedef unsigned u32x2 __attribute__((ext_vector_type(2)));
using pg8::cvt_pk_bf16;
constexpr int NB = 8, SEQ = 8192, D = 1024, M = NB * SEQ, INW = 2304, FF = 2816, GU = 2 * FF, DEPTH = 4, NMOD = 6144;
constexpr float EPS = 1e-6f;
constexpr size_t MiB = 1u << 20;
constexpr size_t WS_MOD = 0;
constexpr size_t WS_WSB = 1 * MiB;
constexpr size_t WS_WPB = WS_WSB + 512 * 1024;
constexpr size_t WS_W = 2 * MiB;
constexpr size_t W_IN_OFF = 0, W_OUT_OFF = 5 * MiB, W_GU_OFF = 7 * MiB, W_DN_OFF = 18 * MiB, W_LAYER = 23 * MiB + 512 * 1024;
constexpr size_t WS_H = 96 * MiB;
constexpr size_t WS_P = 224 * MiB;
constexpr size_t WS_END = 576 * MiB;
constexpr size_t WS_SHW1 = 577 * MiB;
constexpr size_t WS_SHW2 = 578 * MiB;
constexpr size_t WS_RSQA = 579 * MiB, WS_RSQB = 579 * MiB + 512 * 1024;
constexpr size_t WS_XS2 = 580 * MiB;
constexpr size_t WS_END2 = 708 * MiB;
constexpr size_t WS_BAR = WS_END;
static_assert(WS_W + 4 * W_LAYER <= WS_H && WS_H + (size_t)M * D * 2 <= WS_P && WS_P + (size_t)M * FF * 2 <= WS_END, "ws map");
constexpr int LDS_BYTES = 147456;
constexpr int NTHREADS = 512;

__device__ __forceinline__ void grid_bar(unsigned* ctr, unsigned& target) {
    target += gridDim.x;
    asm volatile("s_waitcnt vmcnt(0)" ::: "memory");
    __syncthreads();
    if (threadIdx.x == 0) {
        __builtin_amdgcn_fence(__ATOMIC_RELEASE, "agent");
        asm volatile("s_waitcnt vmcnt(0)" ::: "memory");
        __hip_atomic_fetch_add(ctr, 1u, __ATOMIC_RELAXED, __HIP_MEMORY_SCOPE_AGENT);
        while (__hip_atomic_load(ctr, __ATOMIC_RELAXED, __HIP_MEMORY_SCOPE_AGENT) < target) __builtin_amdgcn_s_sleep(1);
        __builtin_amdgcn_fence(__ATOMIC_ACQUIRE, "agent");
        asm volatile("s_waitcnt vmcnt(0)" ::: "memory");
    }
    __syncthreads();
}
struct Args { const float* in[17]; float* out; unsigned char* ws; int ph_lo, ph_hi; };

__device__ __forceinline__ float wave_sum(float v) {
#pragma unroll
    for (int o = 1; o < 64; o <<= 1) v += __shfl_xor(v, o);
    return v;
}
__device__ __forceinline__ float bf2f(unsigned short b) { return __uint_as_float((unsigned)b << 16); }
__device__ __forceinline__ float bflo(unsigned w) { return __uint_as_float(w << 16); }
__device__ __forceinline__ float bfhi(unsigned w) { return __uint_as_float(w & 0xffff0000u); }
__device__ __forceinline__ int crow(int reg, int h) { return (reg & 3) + 8 * (reg >> 2) + 4 * h; }
#define MFMA32(a, b, c) __builtin_amdgcn_mfma_f32_32x32x16_bf16((a), (b), (c), 0, 0, 0)
typedef short v4i16_t __attribute__((ext_vector_type(4)));
__device__ __forceinline__ s16x4 vtr(LAS const unsigned char* p) { return __builtin_bit_cast(s16x4, __builtin_amdgcn_ds_read_tr16_b64_v4i16((LAS v4i16_t*)p)); }
__device__ __forceinline__ bf16x8 cat8(s16x4 lo, s16x4 hi) { return __builtin_shufflevector(lo, hi, 0, 1, 2, 3, 4, 5, 6, 7); }

__device__ __forceinline__ void phase_pro(const Args& a, LAS unsigned char* lds) {
    const int tid = opaque_tid(), G = gridDim.x, bid = opaque_bid();
    LAS float* sc = (LAS float*)lds; LAS float* red = (LAS float*)(lds + 32768);
    { const float* c = a.in[1];
      for (int i = tid; i < NB * D; i += NTHREADS) { const float v = c[i]; sc[i] = v * pg8::fast_sigmoid(v); } }
    __syncthreads();
    float* mod = (float*)(a.ws + WS_MOD);
    if (MK_PRO_MASK & 1)
    for (int item = bid; item < DEPTH * 192; item += G) {
        const int l = item / 192, cgp = item % 192, kp = tid >> 3, n4 = tid & 7;
        float acc[8][4];
#pragma unroll
        for (int b = 0; b < 8; ++b)
#pragma unroll
            for (int j = 0; j < 4; ++j) acc[b][j] = 0.f;
        const float* wp = a.in[2] + ((size_t)l * D + kp * 16) * NMOD + cgp * 32 + n4 * 4;
#pragma unroll 4
        for (int k = 0; k < 16; ++k) {
            const f32x4 w = *(const f32x4*)(wp + (size_t)k * NMOD);
#pragma unroll
            for (int b = 0; b < 8; ++b) { const float s = sc[b * D + kp * 16 + k]; acc[b][0] += s * w[0]; acc[b][1] += s * w[1]; acc[b][2] += s * w[2]; acc[b][3] += s * w[3]; }
        }
#pragma unroll
        for (int b = 0; b < 8; ++b)
#pragma unroll
            for (int j = 0; j < 4; ++j) red[(kp * 8 + b) * 32 + n4 * 4 + j] = acc[b][j];
        __syncthreads();
        if (tid < 256) { const int b = tid >> 5, col = tid & 31; float s = 0.f;
            for (int k2 = 0; k2 < 64; ++k2) s += red[(k2 * 8 + b) * 32 + col];
            mod[(size_t)(l * 8 + b) * NMOD + cgp * 32 + col] = s + a.in[3][l * NMOD + cgp * 32 + col]; }
        __syncthreads();
    }
    LAS float* tile = (LAS float*)lds;
    if (MK_PRO_MASK & 2)
    for (int it = bid; it < DEPTH * 2944; it += G) {
        const int l = it / 2944; int r = it % 2944;
        const float* W; int K, N, kt, nt, kind = 0; size_t woff;
        if (r < 576) { W = a.in[5] + (size_t)l * D * INW; K = D; N = INW; kt = r / 36; nt = r % 36; woff = W_IN_OFF; }
        else if (r < 832) { r -= 576; W = a.in[12] + (size_t)l * D * D; K = D; N = D; kt = r / 16; nt = r % 16; woff = W_OUT_OFF; }
        else if (r < 2240) { r -= 832; W = a.in[14] + (size_t)l * D * GU; K = D; N = GU; kt = r / 88; nt = r % 88; woff = W_GU_OFF; kind = 1; }
        else { r -= 2240; W = a.in[15] + (size_t)l * FF * D; K = FF; N = D; kt = r / 16; nt = r % 16; woff = W_DN_OFF; }
        bf16_t* WT = (bf16_t*)(a.ws + WS_W + (size_t)l * W_LAYER + woff);
        const int n0 = nt * 64, k0 = kt * 64;
        int dn0 = n0;
        if (kind == 1) { dn0 = n0 < FF ? (n0 / 128) * 256 + (n0 % 128) : ((n0 - FF) / 128) * 256 + 128 + ((n0 - FF) % 128); }
#pragma unroll
        for (int p = 0; p < 2; ++p) { const int row = (tid >> 4) + 32 * p, c4 = tid & 15;
            const f32x4 v = *(const f32x4*)(W + (size_t)(k0 + row) * N + n0 + 4 * c4);
            tile[row * 65 + 4 * c4 + 0] = v[0]; tile[row * 65 + 4 * c4 + 1] = v[1]; tile[row * 65 + 4 * c4 + 2] = v[2]; tile[row * 65 + 4 * c4 + 3] = v[3]; }
        __syncthreads();
        { const int n = tid >> 3, kc = tid & 7; LAS const float* s = tile + (8 * kc) * 65 + n;
          u32x4 o; o.x = cvt_pk_bf16(s[0], s[65]); o.y = cvt_pk_bf16(s[2 * 65], s[3 * 65]); o.z = cvt_pk_bf16(s[4 * 65], s[5 * 65]); o.w = cvt_pk_bf16(s[6 * 65], s[7 * 65]);
          *(u32x4*)(WT + (size_t)(dn0 + n) * K + k0 + 8 * kc) = o; }
        __syncthreads();
    }
    if (MK_PRO_MASK & 4)
    { const float* ws_ = a.in[9]; bf16_t* wsb = (bf16_t*)(a.ws + WS_WSB);
      for (int i = bid * NTHREADS + tid; i < DEPTH * 4 * 128 * 128; i += G * NTHREADS) { const int s = i & 127, t = (i >> 7) & 127; const float v = (s <= t) ? ws_[i] : 0.f; wsb[i] = (bf16_t)(cvt_pk_bf16(v, 0.f) & 0xffffu); }
      const float* wp_ = a.in[6]; bf16_t* wpb = (bf16_t*)(a.ws + WS_WPB);
      for (int i = bid * NTHREADS + tid; i < DEPTH * 4 * 64 * 64; i += G * NTHREADS) { const int c = i & 63, e = (i >> 6) & 63, lg = i >> 12; wpb[i] = (bf16_t)(cvt_pk_bf16(wp_[(lg * 64 + c) * 64 + e], 0.f) & 0xffffu); } }
}

__device__ __forceinline__ void phase_pro2(const Args& a) {
    const int tid = opaque_tid(), lane = tid & 63, wave = tid >> 6, gw = opaque_bid() * 8 + wave, NGW = gridDim.x * 8;
    const int pair = gw & 7, l = pair >> 1, which = pair & 1, N = which ? GU : INW;
    const float* sh = (const float*)(a.ws + WS_MOD) + (size_t)l * 8 * NMOD + (which ? 3072 : 0);
    const bf16_t* WT = (const bf16_t*)(a.ws + WS_W + (size_t)l * W_LAYER + (which ? W_GU_OFF : W_IN_OFF));
    float* out = (float*)(a.ws + (which ? WS_SHW2 : WS_SHW1)) + (size_t)l * 8 * N;
    f32x4 sv[8][4];
#pragma unroll
    for (int b = 0; b < 8; ++b)
#pragma unroll
        for (int j = 0; j < 4; ++j) sv[b][j] = *(const f32x4*)(sh + (size_t)b * NMOD + 16 * lane + 4 * j);
    for (int n = gw >> 3; n < N; n += NGW >> 3) {
        const u32x4 w0 = *(const u32x4*)(WT + (size_t)n * D + 16 * lane), w1 = *(const u32x4*)(WT + (size_t)n * D + 16 * lane + 8);
        const f32x4 f0 = {bflo(w0.x), bfhi(w0.x), bflo(w0.y), bfhi(w0.y)}, f1 = {bflo(w0.z), bfhi(w0.z), bflo(w0.w), bfhi(w0.w)};
        const f32x4 f2 = {bflo(w1.x), bfhi(w1.x), bflo(w1.y), bfhi(w1.y)}, f3 = {bflo(w1.z), bfhi(w1.z), bflo(w1.w), bfhi(w1.w)};
        float r[8];
#pragma unroll
        for (int b = 0; b < 8; ++b) { const f32x4 p = sv[b][0] * f0 + sv[b][1] * f1 + sv[b][2] * f2 + sv[b][3] * f3; r[b] = wave_sum((p[0] + p[1]) + (p[2] + p[3])); }
        if (lane == 0) {
#pragma unroll
            for (int b = 0; b < 8; ++b) out[(size_t)b * N + n] = r[b]; }
    }
}
__device__ __forceinline__ void zero_rows(float* p) {
    for (int i = opaque_bid() * NTHREADS + opaque_tid(); i < M; i += gridDim.x * NTHREADS) p[i] = 0.f;
}

__device__ __forceinline__ void phase_norm(const float* xin, const float* g, const float* sh, const float* sc, bf16_t* hout) {
    const int tid = opaque_tid(), lane = tid & 63, wave = tid >> 6, gw = opaque_bid() * 8 + wave, NGW = gridDim.x * 8;
    const int b = gw & 7, r0 = gw >> 3, rstep = NGW >> 3;
    f32x4 gs[4], sv[4];
#pragma unroll
    for (int j = 0; j < 4; ++j) { const int col = 4 * lane + 256 * j; const f32x4 gg = *(const f32x4*)(g + col), ss = *(const f32x4*)(sc + (size_t)b * NMOD + col);
        gs[j] = gg * (ss + 1.0f); sv[j] = *(const f32x4*)(sh + (size_t)b * NMOD + col); }
    for (int r = r0; r < SEQ; r += rstep) {
        const size_t row = (size_t)b * SEQ + r; const f32x4* xr = (const f32x4*)(xin + row * D) + lane;
        f32x4 v[4]; float s = 0.f;
#pragma unroll
        for (int j = 0; j < 4; ++j) { v[j] = xr[64 * j]; s += (v[j][0] * v[j][0] + v[j][1] * v[j][1]) + (v[j][2] * v[j][2] + v[j][3] * v[j][3]); }
        const float rstd = __builtin_amdgcn_rsqf(wave_sum(s) * (1.0f / D) + EPS);
        u32x2* o = (u32x2*)(hout + row * D) + lane;
#pragma unroll
        for (int j = 0; j < 4; ++j) { const f32x4 y = v[j] * rstd * gs[j] + sv[j]; u32x2 w; w.x = cvt_pk_bf16(y[0], y[1]); w.y = cvt_pk_bf16(y[2], y[3]); o[64 * j] = w; }
    }
}
__device__ __forceinline__ void phase_final(const float* xin, const float* g, float* out) {
    const int tid = opaque_tid(), lane = tid & 63, wave = tid >> 6, gw = opaque_bid() * 8 + wave, NGW = gridDim.x * 8;
    f32x4 gs[4];
#pragma unroll
    for (int j = 0; j < 4; ++j) gs[j] = *(const f32x4*)(g + 4 * lane + 256 * j);
    for (int row = gw; row < M; row += NGW) {
        const f32x4* xr = (const f32x4*)(xin + (size_t)row * D) + lane; f32x4 v[4]; float s = 0.f;
#pragma unroll
        for (int j = 0; j < 4; ++j) { v[j] = xr[64 * j]; s += (v[j][0] * v[j][0] + v[j][1] * v[j][1]) + (v[j][2] * v[j][2] + v[j][3] * v[j][3]); }
        const float rstd = __builtin_amdgcn_rsqf(wave_sum(s) * (1.0f / D) + EPS);
        f32x4* o = (f32x4*)(out + (size_t)row * D) + lane;
#pragma unroll
        for (int j = 0; j < 4; ++j) o[64 * j] = v[j] * rstd * gs[j];
    }
}
__device__ __forceinline__ void attn_unit(int unit, const bf16_t* proj, bf16_t* merged, const float* mn, LAS unsigned char* lds, int wave, int lane) {
    const int b = unit >> 8, q0 = (unit & 255) * 32, n = lane & 31, h = lane >> 5, hd = wave;
    const size_t rowbase = (size_t)b * SEQ;
    constexpr float C1 = 0.125f * 1.4426950408889634f;
    bf16x8 bq[4];
    { const bf16_t* qp = proj + (rowbase + q0 + n) * INW + hd * 64 + 8 * h;
#pragma unroll
      for (int s = 0; s < 4; ++s) bq[s] = *(const bf16x8*)(qp + 16 * s); }
    f32x16 o0, o1;
#pragma unroll
    for (int i = 0; i < 16; ++i) { o0[i] = 0.f; o1[i] = 0.f; }
    float carry = 1.f;
    LAS unsigned char* kl = lds + wave * 9216; LAS unsigned char* vl = kl + 4608;
    const int nkt = min(17, (q0 >> 5) + 1);
    const int q4 = (lane & 15) >> 2, p4 = lane & 3, blk = (lane >> 4) & 1;
    u32x4 kv[4], vv[4];
    const bf16_t* kp = proj + (rowbase + q0) * INW + 512 + hd * 64 + (size_t)(lane >> 3) * INW + (lane & 7) * 8;
#pragma unroll
    for (int i = 0; i < 4; ++i) { kv[i] = *(const u32x4*)(kp + (size_t)(8 * i) * INW); vv[i] = *(const u32x4*)(kp + 512 + (size_t)(8 * i) * INW); }
    for (int kt = 0; kt < nkt; ++kt) {
#pragma unroll
        for (int i = 0; i < 4; ++i) { const int c = lane + 64 * i, row = c >> 3, ch = c & 7; *(LAS u32x4*)(kl + row * 144 + ch * 16) = kv[i]; *(LAS u32x4*)(vl + row * 144 + ch * 16) = vv[i]; }
        if (kt + 1 < nkt) { kp -= (size_t)32 * INW;
#pragma unroll
            for (int i = 0; i < 4; ++i) { kv[i] = *(const u32x4*)(kp + (size_t)(8 * i) * INW); vv[i] = *(const u32x4*)(kp + 512 + (size_t)(8 * i) * INW); } }
        asm volatile("s_waitcnt lgkmcnt(0)" ::: "memory");
        f32x16 st;
#pragma unroll
        for (int i = 0; i < 16; ++i) st[i] = 0.f;
#pragma unroll
        for (int s = 0; s < 4; ++s) { const bf16x8 ka = *(LAS const bf16x8*)(kl + n * 144 + (2 * s + h) * 16); st = MFMA32(ka, bq[s], st); }
        float be[16], om[16], w[16];
#pragma unroll
        for (int i = 0; i < 16; ++i) {
            const float e = __builtin_amdgcn_exp2f(fminf(st[i] * (-C1), 80.f));
            be[i] = __builtin_amdgcn_rcpf(1.0f + e);
            om[i] = e * be[i];
        }
        if (kt == 0 || kt == 16) {
#pragma unroll
            for (int i = 0; i < 16; ++i) { const bool valid = (kt == 0) ? (crow(i, h) < n) : (crow(i, h) >= n); be[i] = valid ? be[i] : 0.f; om[i] = valid ? om[i] : 1.f; }
        }
        const float G0 = (om[0] * om[1]) * (om[2] * om[3]), G1 = (om[4] * om[5]) * (om[6] * om[7]), G2 = (om[8] * om[9]) * (om[10] * om[11]), G3 = (om[12] * om[13]) * (om[14] * om[15]);
        const float P0 = __shfl_xor(G0, 32), P1 = __shfl_xor(G1, 32), P2 = __shfl_xor(G2, 32), P3 = __shfl_xor(G3, 32);
        const float S2 = G3 * P3, S1 = S2 * (G2 * P2), S0 = S1 * (G1 * P1), tot = S0 * (G0 * P0);
        float T[4]; T[0] = S0 * (h == 0 ? P0 : 1.f); T[1] = S1 * (h == 0 ? P1 : 1.f); T[2] = S2 * (h == 0 ? P2 : 1.f); T[3] = (h == 0 ? P3 : 1.f);
#pragma unroll
        for (int g = 0; g < 4; ++g) {
            float later = carry * T[g];
#pragma unroll
            for (int j = 3; j >= 0; --j) { const int i = 4 * g + j; w[i] = be[i] * later; later *= om[i]; }
        }
        carry *= tot;
        const bool done = __builtin_amdgcn_ballot_w64(carry >= 1e-37f) == 0ull;
        bf16x8 wf[2];
#pragma unroll
        for (int s = 0; s < 2; ++s) { u32x4 p; p.x = cvt_pk_bf16(w[8 * s], w[8 * s + 1]); p.y = cvt_pk_bf16(w[8 * s + 2], w[8 * s + 3]); p.z = cvt_pk_bf16(w[8 * s + 4], w[8 * s + 5]); p.w = cvt_pk_bf16(w[8 * s + 6], w[8 * s + 7]); wf[s] = __builtin_bit_cast(bf16x8, p); }
#pragma unroll
        for (int s = 0; s < 2; ++s) {
            LAS const unsigned char* vb = vl + (16 * s + 4 * h + q4) * 144 + 32 * blk + 8 * p4;
            const s16x4 lo0 = vtr(vb), hi0 = vtr(vb + 8 * 144), lo1 = vtr(vb + 64), hi1 = vtr(vb + 8 * 144 + 64);
            o0 = MFMA32(cat8(lo0, hi0), wf[s], o0);
            o1 = MFMA32(cat8(lo1, hi1), wf[s], o1);
        }
        asm volatile("" ::: "memory");
        if (done) break;
    }
    float ss = 0.f;
#pragma unroll
    for (int i = 0; i < 16; ++i) ss += o0[i] * o0[i] + o1[i] * o1[i];
    ss += __shfl_xor(ss, 32);
    LAS float* ex = (LAS float*)(lds + 73728);
    if (h == 0) ex[wave * 32 + n] = ss;
    __syncthreads();
    float tot = 0.f;
#pragma unroll
    for (int w8 = 0; w8 < 8; ++w8) tot += ex[w8 * 32 + n];
    const float rstd = __builtin_amdgcn_rsqf(tot * (1.0f / 512.0f) + EPS);
    bf16_t* op = merged + (rowbase + q0 + n) * D + hd * 64 + 4 * h;
    const float* mp = mn + hd * 64 + 4 * h;
#pragma unroll
    for (int g = 0; g < 4; ++g) {
        const f32x4 m0 = *(const f32x4*)(mp + 8 * g), m1 = *(const f32x4*)(mp + 32 + 8 * g);
        u32x2 a0, a1;
        a0.x = cvt_pk_bf16(o0[4 * g] * rstd * m0[0], o0[4 * g + 1] * rstd * m0[1]); a0.y = cvt_pk_bf16(o0[4 * g + 2] * rstd * m0[2], o0[4 * g + 3] * rstd * m0[3]);
        a1.x = cvt_pk_bf16(o1[4 * g] * rstd * m1[0], o1[4 * g + 1] * rstd * m1[1]); a1.y = cvt_pk_bf16(o1[4 * g + 2] * rstd * m1[2], o1[4 * g + 3] * rstd * m1[3]);
        *(u32x2*)(op + 8 * g) = a0; *(u32x2*)(op + 32 + 8 * g) = a1;
    }
    __syncthreads();
}

__device__ __forceinline__ void sg_unit(int unit, const bf16_t* proj, bf16_t* merged, const float* mn, const float* sgn, const bf16_t* wsb, const float* bs, LAS unsigned char* lds, int tid, int wave, int lane) {
    const size_t R0 = (size_t)unit * 128;
    constexpr int RS = 528;
    { const int t = tid >> 2, part = tid & 3;
      const bf16_t* vp = proj + (R0 + t) * INW + 2048 + 64 * part;
      u32x4 raw[8];
#pragma unroll
      for (int i = 0; i < 8; ++i) raw[i] = *(const u32x4*)(vp + 8 * i);
      float s = 0.f;
#pragma unroll
      for (int i = 0; i < 8; ++i) s += (bflo(raw[i].x) + bfhi(raw[i].x)) + (bflo(raw[i].y) + bfhi(raw[i].y)) + (bflo(raw[i].z) + bfhi(raw[i].z)) + (bflo(raw[i].w) + bfhi(raw[i].w));
      s += __shfl_xor(s, 1); s += __shfl_xor(s, 2);
      const float mean = s * (1.0f / 256.0f);
      float q = 0.f;
#pragma unroll
      for (int i = 0; i < 8; ++i) { float d;
          d = bflo(raw[i].x) - mean; q += d * d; d = bfhi(raw[i].x) - mean; q += d * d; d = bflo(raw[i].y) - mean; q += d * d; d = bfhi(raw[i].y) - mean; q += d * d;
          d = bflo(raw[i].z) - mean; q += d * d; d = bfhi(raw[i].z) - mean; q += d * d; d = bflo(raw[i].w) - mean; q += d * d; d = bfhi(raw[i].w) - mean; q += d * d; }
      q += __shfl_xor(q, 1); q += __shfl_xor(q, 2);
      const float rstd = __builtin_amdgcn_rsqf(q * (1.0f / 256.0f) + EPS);
      const float* gp = sgn + 64 * part;
#pragma unroll
      for (int i = 0; i < 8; ++i) { const f32x4 ga = *(const f32x4*)(gp + 8 * i), gb = *(const f32x4*)(gp + 8 * i + 4); u32x4 o;
          o.x = cvt_pk_bf16((bflo(raw[i].x) - mean) * rstd * ga[0], (bfhi(raw[i].x) - mean) * rstd * ga[1]); o.y = cvt_pk_bf16((bflo(raw[i].y) - mean) * rstd * ga[2], (bfhi(raw[i].y) - mean) * rstd * ga[3]);
          o.z = cvt_pk_bf16((bflo(raw[i].z) - mean) * rstd * gb[0], (bfhi(raw[i].z) - mean) * rstd * gb[1]); o.w = cvt_pk_bf16((bflo(raw[i].w) - mean) * rstd * gb[2], (bfhi(raw[i].w) - mean) * rstd * gb[3]);
          *(LAS u32x4*)(lds + t * RS + 2 * (64 * part + 8 * i)) = o; }
    }
    __syncthreads();
    const int h4 = wave >> 1, dh = wave & 1, n = lane & 31, h = lane >> 5, cbase = 64 * h4 + 32 * dh;
    const int q4 = (lane & 15) >> 2, p4 = lane & 3, blk = (lane >> 4) & 1;
    f32x16 acc[4];
#pragma unroll
    for (int tt = 0; tt < 4; ++tt)
#pragma unroll
        for (int i = 0; i < 16; ++i) acc[tt][i] = 0.f;
#pragma unroll
    for (int ks = 0; ks < 8; ++ks) {
        LAS const unsigned char* vb = lds + (16 * ks + 8 * h + q4) * RS + 2 * (cbase + 16 * blk) + 8 * p4;
        const bf16x8 af = cat8(vtr(vb), vtr(vb + 4 * RS));
#pragma unroll
        for (int tt = 0; tt < 4; ++tt) if (ks < 2 * (tt + 1)) {
            const bf16x8 bfr = *(const bf16x8*)(wsb + (size_t)(h4 * 128 + 32 * tt + n) * 128 + 16 * ks + 8 * h);
            acc[tt] = MFMA32(af, bfr, acc[tt]); }
    }
    LAS float* ex = (LAS float*)(lds + 67584);
#pragma unroll
    for (int tt = 0; tt < 4; ++tt) { const int t = 32 * tt + n; const float bias = bs[h4 * 128 + t]; const bf16_t* up = proj + (R0 + t) * INW + 1792 + cbase + 4 * h; float s = 0.f;
#pragma unroll
        for (int g = 0; g < 4; ++g) { const u32x2 uu = *(const u32x2*)(up + 8 * g);
            const float v0 = bflo(uu.x) * (acc[tt][4 * g] + bias), v1 = bfhi(uu.x) * (acc[tt][4 * g + 1] + bias), v2 = bflo(uu.y) * (acc[tt][4 * g + 2] + bias), v3 = bfhi(uu.y) * (acc[tt][4 * g + 3] + bias);
            acc[tt][4 * g] = v0; acc[tt][4 * g + 1] = v1; acc[tt][4 * g + 2] = v2; acc[tt][4 * g + 3] = v3; s += (v0 * v0 + v1 * v1) + (v2 * v2 + v3 * v3); }
        s += __shfl_xor(s, 32);
        if (h == 0) ex[wave * 128 + t] = s; }
    __syncthreads();
#pragma unroll
    for (int tt = 0; tt < 4; ++tt) { const int t = 32 * tt + n; float tot = 0.f;
#pragma unroll
        for (int w8 = 0; w8 < 8; ++w8) tot += ex[w8 * 128 + t];
        const float rstd = __builtin_amdgcn_rsqf(tot * (1.0f / 256.0f) + EPS);
        bf16_t* op = merged + (R0 + t) * D + 768 + cbase + 4 * h; const float* mp = mn + 768 + cbase + 4 * h;
#pragma unroll
        for (int g = 0; g < 4; ++g) { const f32x4 m0 = *(const f32x4*)(mp + 8 * g); u32x2 a0;
            a0.x = cvt_pk_bf16(acc[tt][4 * g] * rstd * m0[0], acc[tt][4 * g + 1] * rstd * m0[1]); a0.y = cvt_pk_bf16(acc[tt][4 * g + 2] * rstd * m0[2], acc[tt][4 * g + 3] * rstd * m0[3]);
            *(u32x2*)(op + 8 * g) = a0; } }
    __syncthreads();
}

__device__ __forceinline__ void pool_unit(int unit, const bf16_t* proj, bf16_t* merged, const float* mn, const bf16_t* wpb, const float* pscale, LAS unsigned char* lds, int tid, int wave, int lane) {
    const size_t T0 = (size_t)unit * 128; const int pos0 = (unit & 63) * 128;
    constexpr int RS = 528;
    for (int c = tid; c < 144 * 32; c += NTHREADS) { const int li = c >> 5, ch = c & 31; u32x4 v = (u32x4){0u, 0u, 0u, 0u};
        if (li >= 16 || pos0 > 0) v = *(const u32x4*)(proj + (T0 + li - 16) * INW + 1536 + 8 * ch);
        *(LAS u32x4*)(lds + li * RS + 16 * ch) = v; }
    __syncthreads();
    const int g = wave >> 1, eh = wave & 1, n = lane & 31, h = lane >> 5, W = 2 << g;
    f32x16 acc[4];
#pragma unroll
    for (int tt = 0; tt < 4; ++tt)
#pragma unroll
        for (int i = 0; i < 16; ++i) acc[tt][i] = 0.f;
    bf16x8 af[4];
#pragma unroll
    for (int ks = 0; ks < 4; ++ks) af[ks] = *(const bf16x8*)(wpb + (size_t)(g * 64 + 32 * eh + n) * 64 + 16 * ks + 8 * h);
#pragma unroll
    for (int tt = 0; tt < 4; ++tt) {
        const int li = 16 + 32 * tt + n, pos = pos0 + 32 * tt + n; const float inv = 1.0f / (float)min(pos + 1, W);
#pragma unroll
        for (int ks = 0; ks < 4; ++ks) {
            LAS const unsigned char* pb = lds + li * RS + 2 * (64 * g + 16 * ks + 8 * h);
            float sm[8];
#pragma unroll
            for (int k = 0; k < 8; ++k) sm[k] = 0.f;
            for (int j = 0; j < W; ++j) { const u32x4 v = *(LAS const u32x4*)(pb - j * RS);
                sm[0] += bflo(v.x); sm[1] += bfhi(v.x); sm[2] += bflo(v.y); sm[3] += bfhi(v.y); sm[4] += bflo(v.z); sm[5] += bfhi(v.z); sm[6] += bflo(v.w); sm[7] += bfhi(v.w); }
            const u32x4 own = *(LAS const u32x4*)pb; u32x4 p;
            p.x = cvt_pk_bf16(sm[0] * inv - bflo(own.x), sm[1] * inv - bfhi(own.x)); p.y = cvt_pk_bf16(sm[2] * inv - bflo(own.y), sm[3] * inv - bfhi(own.y));
            p.z = cvt_pk_bf16(sm[4] * inv - bflo(own.z), sm[5] * inv - bfhi(own.z)); p.w = cvt_pk_bf16(sm[6] * inv - bflo(own.w), sm[7] * inv - bfhi(own.w));
            acc[tt] = MFMA32(af[ks], __builtin_bit_cast(bf16x8, p), acc[tt]);
        }
    }
    LAS float* ex = (LAS float*)(lds + 76032);
    const int ebase = 64 * g + 32 * eh + 4 * h;
#pragma unroll
    for (int tt = 0; tt < 4; ++tt) { float s = 0.f;
#pragma unroll
        for (int gg = 0; gg < 4; ++gg) { const f32x4 ps = *(const f32x4*)(pscale + ebase + 8 * gg);
#pragma unroll
            for (int j = 0; j < 4; ++j) { const float v = acc[tt][4 * gg + j] * ps[j]; acc[tt][4 * gg + j] = v; s += v * v; } }
        s += __shfl_xor(s, 32);
        if (h == 0) ex[wave * 128 + 32 * tt + n] = s; }
    __syncthreads();
#pragma unroll
    for (int tt = 0; tt < 4; ++tt) { const int t = 32 * tt + n; float tot = 0.f;
#pragma unroll
        for (int w8 = 0; w8 < 8; ++w8) tot += ex[w8 * 128 + t];
        const float rstd = __builtin_amdgcn_rsqf(tot * (1.0f / 256.0f) + EPS);
        bf16_t* op = merged + (T0 + t) * D + 512 + ebase; const float* mp = mn + 512 + ebase;
#pragma unroll
        for (int gg = 0; gg < 4; ++gg) { const f32x4 m0 = *(const f32x4*)(mp + 8 * gg); u32x2 a0;
            a0.x = cvt_pk_bf16(acc[tt][4 * gg] * rstd * m0[0], acc[tt][4 * gg + 1] * rstd * m0[1]); a0.y = cvt_pk_bf16(acc[tt][4 * gg + 2] * rstd * m0[2], acc[tt][4 * gg + 3] * rstd * m0[3]);
            *(u32x2*)(op + 8 * gg) = a0; } }
    __syncthreads();
}

__device__ __forceinline__ void phase_mix(const Args& a, int l, LAS unsigned char* lds) {
    const int tid = opaque_tid(), lane = tid & 63, wave = __builtin_amdgcn_readfirstlane(tid >> 6), G = gridDim.x, bid = opaque_bid();
    const bf16_t* proj = (const bf16_t*)(a.ws + WS_P); bf16_t* merged = (bf16_t*)(a.ws + WS_H);
    const float* mn = a.in[11] + (size_t)l * D;
    { const int per = (M / 32 + G - 1) / G;
      for (int u = bid * per; u < min(M / 32, (bid + 1) * per); ++u) attn_unit(u, proj, merged, mn, lds, wave, lane); }
    { const float* sgn = a.in[8] + l * 256; const bf16_t* wsb = (const bf16_t*)(a.ws + WS_WSB) + (size_t)l * 4 * 128 * 128; const float* bs = a.in[10] + l * 4 * 128;
      for (int u = bid; u < M / 128; u += G) sg_unit(u, proj, merged, mn, sgn, wsb, bs, lds, tid, wave, lane); }
    { const bf16_t* wpb = (const bf16_t*)(a.ws + WS_WPB) + (size_t)l * 4 * 64 * 64; const float* pscale = a.in[7] + l * 256;
      for (int u = bid; u < M / 128; u += G) pool_unit(u, proj, merged, mn, wpb, pscale, lds, tid, wave, lane); }
}
constexpr int N_STEPS = 3 + 5 * DEPTH;
__global__ void __launch_bounds__(NTHREADS, 2) fwd(Args args) {
    extern __shared__ __attribute__((aligned(16))) unsigned char lds_raw[];
    LAS unsigned char* lds = (LAS unsigned char*)lds_raw;
#if MK_ONE_LAUNCH
#define SEAM() grid_bar(bar_ctr, bar_target)
#define SEAM_CG() do { __syncthreads(); cg::this_grid().sync(); } while (0)
#else
#define SEAM() do { } while (0)
#define SEAM_CG() do { } while (0)
#endif
#define RUN(k) (args.ph_lo <= (k) && (k) < args.ph_hi && (k) < MK_MAX_STEP)
    unsigned char* ws = args.ws;
    const float* mod = (const float*)(ws + WS_MOD);
    bf16_t* hbuf = (bf16_t*)(ws + WS_H); bf16_t* pbuf = (bf16_t*)(ws + WS_P);
    unsigned* bar_ctr = (unsigned*)(ws + WS_BAR); unsigned bar_target = 0u; (void)bar_ctr; (void)bar_target;
    if (RUN(0)) phase_pro(args, lds);
    SEAM_CG();
    bf16_t* xs2 = (bf16_t*)(ws + WS_XS2); float* rsqA = (float*)(ws + WS_RSQA); float* rsqB = (float*)(ws + WS_RSQB);
    if (RUN(1)) { phase_pro2(args); phase_norm(args.in[0], args.in[4], mod, mod + 1024, hbuf); }
    SEAM();
#pragma nounroll
    for (int l = 0; l < DEPTH; ++l) {
        const int s0 = 2 + 5 * l;
        const float* xin = (l == 0) ? args.in[0] : args.out;
        const float* modl = mod + (size_t)l * 8 * NMOD;
        const unsigned char* wl = ws + WS_W + (size_t)l * W_LAYER;
        if (RUN(s0 + 0)) { zero_rows(rsqA);
            pg8::Gemm g{hbuf, (const bf16_t*)(wl + W_IN_OFF), M, INW, D}; pg8::StaticOrder S; S.init(M, INW, gridDim.x, opaque_bid());
            pg8::EpiProj E{pbuf, l == 0 ? nullptr : rsqB, (const float*)(ws + WS_SHW1) + (size_t)l * 8 * INW};
            pg8::gemm_phase<pg8::EpiProj, pg8::StaticOrder, true, true>(lds, g, S, E); }
        SEAM();
        if (RUN(s0 + 1)) phase_mix(args, l, lds);
        SEAM();
        if (RUN(s0 + 2)) { pg8::Gemm g{hbuf, (const bf16_t*)(wl + W_OUT_OFF), M, D, D}; pg8::StaticOrder S; S.init(M, D, gridDim.x, opaque_bid());
            pg8::EpiRes E{xin, args.out, modl + 2048, xs2, rsqA, args.in[13] + l * D, modl + 4096};
            pg8::gemm_phase<pg8::EpiRes, pg8::StaticOrder, true, true>(lds, g, S, E); }
        SEAM();
        if (RUN(s0 + 3)) { zero_rows(rsqB);
            pg8::Gemm g{xs2, (const bf16_t*)(wl + W_GU_OFF), M, GU, D}; pg8::StaticOrder S; S.init(M, GU, gridDim.x, opaque_bid());
            pg8::EpiSwiglu E{pbuf, rsqA, (const float*)(ws + WS_SHW2) + (size_t)l * 8 * GU};
            pg8::gemm_phase<pg8::EpiSwiglu, pg8::StaticOrder, true, true>(lds, g, S, E); }
        SEAM();
        if (RUN(s0 + 4)) { const bool last = (l == DEPTH - 1); const int ln = last ? l : l + 1;
            pg8::Gemm g{pbuf, (const bf16_t*)(wl + W_DN_OFF), M, D, FF}; pg8::StaticOrder S; S.init(M, D, gridDim.x, opaque_bid());
            pg8::EpiRes E{args.out, args.out, modl + 5120, last ? nullptr : hbuf, rsqB, args.in[4] + ln * D, mod + (size_t)ln * 8 * NMOD + 1024};
            pg8::gemm_phase<pg8::EpiRes, pg8::StaticOrder, true, true>(lds, g, S, E); }
        SEAM();
    }
    if (RUN(N_STEPS - 1)) phase_final(args.out, args.in[16], args.out);
#undef RUN
#undef SEAM
#undef SEAM_CG
}

extern "C" void kernel_launch(void* const* d_in, const int* in_sizes, int n_in, void* d_out, int out_size, void* d_ws, size_t ws_size, hipStream_t stream) {
    static int grid = 0;
    if (grid == 0) {
        if (n_in != 17 || in_sizes[0] != M * D || out_size != M * D || ws_size < WS_END2) { fprintf(stderr, "kernel_launch: unexpected shapes (n_in %d in0 %d out %d ws %zu)\n", n_in, n_in > 0 ? in_sizes[0] : -1, out_size, ws_size); grid = -1; return; }
        int dev = 0, cus = 0, per_cu = 0;
        if (hipGetDevice(&dev) != hipSuccess || hipDeviceGetAttribute(&cus, hipDeviceAttributeMultiprocessorCount, dev) != hipSuccess) { grid = -1; return; }
        if (hipFuncSetAttribute((const void*)fwd, hipFuncAttributeMaxDynamicSharedMemorySize, LDS_BYTES) != hipSuccess) { fprintf(stderr, "kernel_launch: hipFuncSetAttribute failed\n"); grid = -1; return; }
        if (hipOccupancyMaxActiveBlocksPerMultiprocessor(&per_cu, (const void*)fwd, NTHREADS, LDS_BYTES) != hipSuccess || per_cu < 1) { fprintf(stderr, "kernel_launch: occupancy query gave %d\n", per_cu); per_cu = 1; }
        (void)hipGetLastError();
        grid = cus * per_cu;
    }
    if (grid < 0) return;
    Args a{};
    for (int i = 0; i < 17; ++i) a.in[i] = (const float*)d_in[i];
    a.out = (float*)d_out; a.ws = (unsigned char*)d_ws;
#if MK_ONE_LAUNCH
    if (hipMemsetAsync((char*)d_ws + WS_BAR, 0, 256, stream) != hipSuccess) { fprintf(stderr, "kernel_launch: memset failed\n"); return; }
    a.ph_lo = 0; a.ph_hi = N_STEPS;
    void* params[] = {&a};
    hipError_t e = hipLaunchCooperativeKernel((const void*)fwd, dim3(grid), dim3(NTHREADS), params, LDS_BYTES, stream);
    if (e != hipSuccess) fprintf(stderr, "cooperative launch failed: %s (grid %d)\n", hipGetErrorString(e), grid);
#else
    for (int k = 0; k < N_STEPS && k < (MK_MAX_STEP > 0 ? MK_MAX_STEP : 1); ++k) { a.ph_lo = k; a.ph_hi = k + 1; hipLaunchKernelGGL(fwd, dim3(grid), dim3(NTHREADS), LDS_BYTES, stream, a); }
#endif
}
```

```cpp
#include <hip/hip_runtime.h>
#include <hip/hip_cooperative_groups.h>
#include <cstdio>
#include <cstdint>
namespace cg = cooperative_groups;
#ifndef MK_MAX_STEP
#define MK_MAX_STEP 100
#define MK_PRO_MASK 7
#endif
#ifndef MK_ONE_LAUNCH
#define MK_ONE_LAUNCH 1
#endif
__device__ __forceinline__ int opaque_tid() { int t = threadIdx.x; asm volatile("" : "+v"(t)); return t; }
__device__ __forceinline__ int opaque_bid() { int b = blockIdx.x; asm volatile("" : "+s"(b)); return b; }
namespace pg8 {
#define PG8_LAS __attribute__((address_space(3)))
typedef unsigned short bf16_t;
typedef short bf16x8 __attribute__((ext_vector_type(8)));
typedef float f32x4 __attribute__((ext_vector_type(4)));
typedef unsigned u32x4 __attribute__((ext_vector_type(4)));
constexpr int BM = 256, BK = 64, HALF = 128, HTB = HALF * BK * 2  , STAGE_BYTES = 8 * HTB, NXCD = 8, WGM = 8;

__host__ __device__ __forceinline__ int lds_byte(int r, int c) { const int st = (r >> 4) * 2 + (c >> 5), rr = r & 15, cc = c & 31, ob = rr * 64 + cc * 2; return st * 1024 + (ob ^ (((ob >> 9) & 1) << 5)); }
__host__ __device__ __forceinline__ void stage_rc(int b, int& R, int& C) { const int st = b / 1024, sb = b % 1024, swz = sb ^ (((sb >> 9) & 1) << 5); R = (st >> 1) * 16 + swz / 64; C = (st & 1) * 32 + (swz % 64) / 2; }
__host__ __device__ __forceinline__ int perm32(int rho) { const int n = rho >> 4, i = rho & 15; return 8 * (i >> 2) + 4 * n + (i & 3); }

struct Unit { int pm, pn; };
struct Gemm { const bf16_t* A; const bf16_t* Bt; int M, N, K; };

struct StaticOrder {
    int nM, nN, nwg, G, c;
    __host__ __device__ void init(int M, int N, int G_, int c_) { nM = M / BM; nN = N / BM; nwg = nM * nN; G = G_; c = c_; }
    __host__ __device__ bool next(int i, Unit& u) const {
        const long L = (long)i * G + c; if (L >= nwg) return false;
        int wgid = (int)L; { const int q = nwg / NXCD, r = nwg % NXCD, xcd = wgid % NXCD, off = wgid / NXCD; wgid = (xcd < r ? xcd * (q + 1) : r * (q + 1) + (xcd - r) * q) + off; }
        const int nig = WGM * nN, gid = wgid / nig, fm = gid * WGM, gsz = (nM - fm) < WGM ? (nM - fm) : WGM;
        u.pm = fm + ((wgid % nig) % gsz); u.pn = (wgid % nig) / gsz; return true;
    }
    __device__ __forceinline__ void a_ready(const Unit&) const {}
    __device__ __forceinline__ void done(const Unit&) const {}
};

typedef unsigned u32x2 __attribute__((ext_vector_type(2)));
typedef float f32x2 __attribute__((ext_vector_type(2)));
typedef __bf16 bf16x2_t __attribute__((ext_vector_type(2)));
__device__ __forceinline__ unsigned cvt_pk_bf16(float lo, float hi) { f32x2 v = {lo, hi}; bf16x2_t b = __builtin_convertvector(v, bf16x2_t); return __builtin_bit_cast(unsigned, b); }
__device__ __forceinline__ float fast_sigmoid(float x) { return __builtin_amdgcn_rcpf(1.0f + __builtin_amdgcn_exp2f(-1.4426950408889634f * x)); }
__device__ __forceinline__ float gelu_tanh(float x) { const float u = 0.7978845608028654f * (x + 0.044715f * x * x * x); return x * fast_sigmoid(2.0f * u); }
__device__ __forceinline__ float silu_f(float x) { return x * fast_sigmoid(x); }

struct EpiProj {
    static constexpr bool PERM = true, AFTER_DRAIN = false;
    bf16_t* O; const float* rowsq; const float* shw;
    __device__ __forceinline__ void operator()(const f32x4 (&acc)[2][2][4][2], const Unit& u, int wr, int wc, int fr, int fq) const {
        const int row0 = u.pm * BM + wr * 64 + fr, col0 = u.pn * BM + wc * 32 + 8 * fq; const bool act = u.pn >= 7;
        f32x4 bv[2][2];
#pragma unroll
        for (int bj = 0; bj < 2; ++bj)
#pragma unroll
            for (int n = 0; n < 2; ++n) bv[bj][n] = rowsq ? *(const f32x4*)(shw + (size_t)(u.pm >> 5) * 2304 + col0 + bj * HALF + 4 * n) : (f32x4){0.f, 0.f, 0.f, 0.f};
        float rsv[2][4];
#pragma unroll
        for (int ai = 0; ai < 2; ++ai)
#pragma unroll
            for (int m = 0; m < 4; ++m) rsv[ai][m] = rowsq ? rowsq[row0 + ai * HALF + m * 16] : 0.f;
#pragma unroll
        for (int ai = 0; ai < 2; ++ai)
#pragma unroll
            for (int m = 0; m < 4; ++m) { bf16_t* rowp = O + (size_t)(row0 + ai * HALF + m * 16) * 2304 + col0;
                const float rs = rowsq ? __builtin_amdgcn_rsqf(rsv[ai][m] * (1.0f / 1024.0f) + 1e-6f) : 1.0f;
#pragma unroll
                for (int bj = 0; bj < 2; ++bj) { f32x4 v0 = acc[ai][bj][m][0] * rs + bv[bj][0], v1 = acc[ai][bj][m][1] * rs + bv[bj][1];
                    if (act) { v0 = (f32x4){gelu_tanh(v0[0]), gelu_tanh(v0[1]), gelu_tanh(v0[2]), gelu_tanh(v0[3])}; v1 = (f32x4){gelu_tanh(v1[0]), gelu_tanh(v1[1]), gelu_tanh(v1[2]), gelu_tanh(v1[3])}; }
                    u32x4 w; w.x = cvt_pk_bf16(v0[0], v0[1]); w.y = cvt_pk_bf16(v0[2], v0[3]); w.z = cvt_pk_bf16(v1[0], v1[1]); w.w = cvt_pk_bf16(v1[2], v1[3]);
                    *(u32x4*)(rowp + bj * HALF) = w; } }
    }
};
struct EpiSwiglu {
    static constexpr bool PERM = true, AFTER_DRAIN = false;
    bf16_t* O; const float* rowsq; const float* shw;
    __device__ __forceinline__ void operator()(const f32x4 (&acc)[2][2][4][2], const Unit& u, int wr, int wc, int fr, int fq) const {
        const int row0 = u.pm * BM + wr * 64 + fr, col0 = u.pn * HALF + wc * 32 + 8 * fq;
        const float* sp = shw + (size_t)(u.pm >> 5) * 5632 + u.pn * BM + wc * 32 + 8 * fq;
        const f32x4 bg0 = *(const f32x4*)(sp), bg1 = *(const f32x4*)(sp + 4), bu0 = *(const f32x4*)(sp + HALF), bu1 = *(const f32x4*)(sp + HALF + 4);
        float rsv[2][4];
#pragma unroll
        for (int ai = 0; ai < 2; ++ai)
#pragma unroll
            for (int m = 0; m < 4; ++m) rsv[ai][m] = rowsq[row0 + ai * HALF + m * 16];
#pragma unroll
        for (int ai = 0; ai < 2; ++ai)
#pragma unroll
            for (int m = 0; m < 4; ++m) { bf16_t* rowp = O + (size_t)(row0 + ai * HALF + m * 16) * 2816 + col0;
                const float rs = __builtin_amdgcn_rsqf(rsv[ai][m] * (1.0f / 1024.0f) + 1e-6f);
                const f32x4 g0 = acc[ai][0][m][0] * rs + bg0, g1 = acc[ai][0][m][1] * rs + bg1, u0 = acc[ai][1][m][0] * rs + bu0, u1 = acc[ai][1][m][1] * rs + bu1;
                u32x4 w; w.x = cvt_pk_bf16(silu_f(g0[0]) * u0[0], silu_f(g0[1]) * u0[1]); w.y = cvt_pk_bf16(silu_f(g0[2]) * u0[2], silu_f(g0[3]) * u0[3]);
                w.z = cvt_pk_bf16(silu_f(g1[0]) * u1[0], silu_f(g1[1]) * u1[1]); w.w = cvt_pk_bf16(silu_f(g1[2]) * u1[2], silu_f(g1[3]) * u1[3]);
                *(u32x4*)rowp = w; }
    }
};
struct EpiRes {
    static constexpr bool PERM = false, AFTER_DRAIN = false;
    const float* xin; float* xout; const float* gate;
    bf16_t* xs; float* rowsq; const float* gst;
    __device__ __forceinline__ void operator()(f32x4 (&acc)[2][2][4][2], const Unit& u, int wr, int wc, int fr, int fq) const {
        const int col0 = u.pn * BM + wc * 32 + 4 * fq; const float* gp = gate + (size_t)(u.pm >> 5) * 6144 + col0;
        const size_t base = (size_t)(u.pm * BM + wr * 64 + fr) * 1024 + col0;
        f32x4 xb[3][4];
#define EPIRES_LOAD(G) do { _Pragma("unroll") for (int bj_ = 0; bj_ < 2; ++bj_) _Pragma("unroll") for (int n_ = 0; n_ < 2; ++n_) \
            xb[(G) % 3][bj_ * 2 + n_] = *(const f32x4*)(xin + base + (size_t)(((G) >> 2) * HALF + ((G) & 3) * 16) * 1024 + bj_ * HALF + n_ * 16); } while (0)
        EPIRES_LOAD(0); EPIRES_LOAD(1);
        f32x4 gs[2][2];
        { f32x4 gv[2][2];
#pragma unroll
          for (int bj = 0; bj < 2; ++bj)
#pragma unroll
              for (int n = 0; n < 2; ++n) { gv[bj][n] = *(const f32x4*)(gp + bj * HALF + n * 16);
                  gs[bj][n] = xs ? *(const f32x4*)(gst + (size_t)(u.pm >> 5) * 1024 + col0 + bj * HALF + n * 16) : (f32x4){0.f, 0.f, 0.f, 0.f}; }
#pragma unroll
          for (int ai = 0; ai < 2; ++ai)
#pragma unroll
              for (int bj = 0; bj < 2; ++bj)
#pragma unroll
                  for (int m = 0; m < 4; ++m)
#pragma unroll
                      for (int n = 0; n < 2; ++n) acc[ai][bj][m][n] *= gv[bj][n]; }
#pragma unroll
        for (int g = 0; g < 8; ++g) { const int ai = g >> 2, m = g & 3;
            if (g + 2 < 8) EPIRES_LOAD(g + 2);
            { const int row = u.pm * BM + ai * HALF + wr * 64 + m * 16 + fr; const size_t off = (size_t)row * 1024 + col0; float ssq = 0.f;
#pragma unroll
                for (int bj = 0; bj < 2; ++bj)
#pragma unroll
                    for (int n = 0; n < 2; ++n) { const f32x4 xv = xb[g % 3][bj * 2 + n];
                        const f32x4 o = xv + acc[ai][bj][m][n];
                        *(f32x4*)(xout + off + bj * HALF + n * 16) = o;
                        if (xs) { ssq += (o[0] * o[0] + o[1] * o[1]) + (o[2] * o[2] + o[3] * o[3]); const f32x4 y = o * gs[bj][n];
                            u32x2 w; w.x = cvt_pk_bf16(y[0], y[1]); w.y = cvt_pk_bf16(y[2], y[3]); *(u32x2*)(xs + off + bj * HALF + n * 16) = w; } }
                if (xs) { ssq += __shfl_xor(ssq, 16); ssq += __shfl_xor(ssq, 32);
                    if (fq == 0) __hip_atomic_fetch_add(rowsq + row, ssq, __ATOMIC_RELAXED, __HIP_MEMORY_SCOPE_AGENT); } } }
#undef EPIRES_LOAD
    }
};
template <class Epi, class Sched, bool ALIGN_EPI = false, bool SP2 = false>
__device__ __forceinline__ void gemm_phase(PG8_LAS unsigned char* lds, const Gemm g, const Sched& S, const Epi& E) {
    const int tid = opaque_tid(), wid = __builtin_amdgcn_readfirstlane(tid >> 6), lane = tid & 63, wr = wid >> 2, wc = wid & 3, fr = lane & 15, fq = lane >> 4;
    const int K = g.K, nt = K / BK;
    unsigned voffA[2], voffB[2];
#pragma unroll
    for (int i = 0; i < 2; ++i) { int R, C; stage_rc(tid * 16 + i * 8192, R, C); const int Rb = Epi::PERM ? ((R & ~31) + perm32(R & 31)) : R;
        voffA[i] = (unsigned)(R * K + C) * 2u; voffB[i] = (unsigned)(Rb * K + C) * 2u; }
    const size_t kstep = (size_t)(BK * 2);
    const size_t hstep = (size_t)HALF * K * 2;
    const size_t tstep = 2 * hstep;
    const unsigned ldsw = (unsigned)wid * 1024u;
    const int aoff = lds_byte(wr * 64 + fr, fq * 8), boff = lds_byte(wc * 32 + fr, fq * 8);
#define PG8_SA(b, h) (((b) * 2 + (h)) * HTB)
#define PG8_SB(b, h) ((4 + (b) * 2 + (h)) * HTB)
#define PG8_STAGE(bufoff, gbase, voff) do { _Pragma("unroll") for (int _i = 0; _i < 2; ++_i) \
        __builtin_amdgcn_global_load_lds((const unsigned*)((const char*)(gbase) + (voff)[_i]), (PG8_LAS unsigned*)(lds + (bufoff) + ldsw + _i * 8192), 16, 0, 0); } while (0)
#define PG8_LDA(dst, b, h) do { _Pragma("unroll") for (int m = 0; m < 4; ++m) _Pragma("unroll") for (int k = 0; k < 2; ++k) dst[m][k] = *(const PG8_LAS bf16x8*)(lds + PG8_SA(b, h) + aoff + m * 2048 + k * 1024); } while (0)
#define PG8_LDB(dst, b, h) do { _Pragma("unroll") for (int n = 0; n < 2; ++n) _Pragma("unroll") for (int k = 0; k < 2; ++k) dst[n][k] = *(const PG8_LAS bf16x8*)(lds + PG8_SB(b, h) + boff + n * 2048 + k * 1024); } while (0)
#define PG8_MMA(ai, bj, At, Bt) do { __builtin_amdgcn_s_setprio(1); _Pragma("unroll") for (int m = 0; m < 4; ++m) _Pragma("unroll") for (int n = 0; n < 2; ++n) _Pragma("unroll") for (int k = 0; k < 2; ++k) \
        acc[ai][bj][m][n] = __builtin_amdgcn_mfma_f32_16x16x32_bf16(Bt[n][k], At[m][k], acc[ai][bj][m][n], 0, 0, 0); __builtin_amdgcn_s_setprio(0); } while (0)
#define PG8_WAIT_V(n) asm volatile("s_waitcnt vmcnt(" #n ")" ::: "memory")
#define PG8_WAIT_L(n) asm volatile("s_waitcnt lgkmcnt(" #n ")" ::: "memory")
#define PG8_BAR __builtin_amdgcn_s_barrier()
#define PG8_SCHED __builtin_amdgcn_sched_barrier(0)
    Unit cur, nxt; int ui = 0;
    if (!S.next(0, cur)) return;
    f32x4 acc[2][2][4][2];
#pragma unroll
    for (int a = 0; a < 2; ++a)
#pragma unroll
        for (int b = 0; b < 2; ++b)
#pragma unroll
            for (int m = 0; m < 4; ++m)
#pragma unroll
                for (int n = 0; n < 2; ++n) acc[a][b][m][n] = (f32x4){0.f, 0.f, 0.f, 0.f};
    bf16x8 At[4][2], B0[2][2], B1[2][2];
    const char* cA = (const char*)g.A + (size_t)cur.pm * tstep; const char* cB = (const char*)g.Bt + (size_t)cur.pn * tstep;
    S.a_ready(cur);
    if constexpr (SP2) {
        PG8_STAGE(PG8_SB(0, 0), cB, voffB); PG8_STAGE(PG8_SB(0, 1), cB + hstep, voffB); PG8_STAGE(PG8_SA(0, 0), cA, voffA); PG8_STAGE(PG8_SA(0, 1), cA + hstep, voffA);
        if (wr == 1) PG8_BAR;
        PG8_WAIT_V(2); PG8_BAR;
        PG8_STAGE(PG8_SB(1, 0), cB + kstep, voffB); PG8_STAGE(PG8_SA(1, 0), cA + kstep, voffA); PG8_STAGE(PG8_SB(1, 1), cB + hstep + kstep, voffB);
        PG8_WAIT_V(6); PG8_BAR;
    } else {
        PG8_STAGE(PG8_SB(0, 0), cB, voffB); PG8_STAGE(PG8_SA(0, 0), cA, voffA); PG8_STAGE(PG8_SB(0, 1), cB + hstep, voffB); PG8_STAGE(PG8_SA(0, 1), cA + hstep, voffA);
        if (wr == 1) PG8_BAR;
        PG8_WAIT_V(4); PG8_BAR;
        PG8_STAGE(PG8_SB(1, 0), cB + kstep, voffB); PG8_STAGE(PG8_SA(1, 0), cA + kstep, voffA); PG8_STAGE(PG8_SB(1, 1), cB + hstep + kstep, voffB);
        PG8_WAIT_V(6); PG8_BAR;
    }
    for (;;) {
        const bool has_next = S.next(ui + 1, nxt);
        const char* nA = has_next ? (const char*)g.A + (size_t)nxt.pm * tstep : cA; const char* nB = has_next ? (const char*)g.Bt + (size_t)nxt.pn * tstep : cB;
        for (int t = 0; t < nt; t += 2) {
            const bool last = (t == nt - 2);
            const char* a1 = cA + (size_t)(t + 1) * kstep;
            const char* a2 = last ? nA : cA + (size_t)(t + 2) * kstep; const char* b2 = last ? nB : cB + (size_t)(t + 2) * kstep;
            const char* a3 = a2 + kstep; const char* b3 = b2 + kstep;
            if (last && has_next) S.a_ready(nxt);
            if constexpr (SP2) {
            PG8_LDB(B0, 0, 0); PG8_LDB(B1, 0, 1); PG8_SCHED; PG8_LDA(At, 0, 0); PG8_STAGE(PG8_SA(1, 1), a1 + hstep, voffA);
            PG8_WAIT_V(8); PG8_WAIT_L(0); PG8_BAR; PG8_MMA(0, 0, At, B0); PG8_MMA(0, 1, At, B1); PG8_BAR; PG8_SCHED;
            PG8_LDA(At, 0, 1); PG8_STAGE(PG8_SB(0, 0), b2, voffB); PG8_STAGE(PG8_SB(0, 1), b2 + hstep, voffB); PG8_STAGE(PG8_SA(0, 0), a2, voffA);
            PG8_WAIT_V(8); PG8_WAIT_L(0); PG8_BAR; PG8_MMA(1, 0, At, B0); PG8_MMA(1, 1, At, B1); PG8_BAR; PG8_SCHED;
            PG8_LDB(B0, 1, 0); PG8_LDB(B1, 1, 1); PG8_SCHED; PG8_LDA(At, 1, 0); PG8_STAGE(PG8_SA(0, 1), a2 + hstep, voffA);
            PG8_WAIT_V(8); PG8_WAIT_L(0); PG8_BAR; PG8_MMA(0, 0, At, B0); PG8_MMA(0, 1, At, B1); PG8_BAR; PG8_SCHED;
            PG8_LDA(At, 1, 1); PG8_STAGE(PG8_SB(1, 0), b3, voffB); PG8_STAGE(PG8_SB(1, 1), b3 + hstep, voffB); PG8_STAGE(PG8_SA(1, 0), a3, voffA);
            PG8_WAIT_V(8); PG8_WAIT_L(0); PG8_BAR; PG8_MMA(1, 0, At, B0); PG8_MMA(1, 1, At, B1); PG8_BAR; PG8_SCHED;
            } else {
            PG8_LDB(B0, 0, 0); PG8_SCHED; PG8_LDA(At, 0, 0); PG8_STAGE(PG8_SA(1, 1), a1 + hstep, voffA);
            PG8_WAIT_L(8); PG8_BAR; PG8_WAIT_L(0); PG8_MMA(0, 0, At, B0); PG8_BAR; PG8_SCHED;
            PG8_LDB(B1, 0, 1); PG8_STAGE(PG8_SB(0, 0), b2, voffB);
            PG8_BAR; PG8_WAIT_L(0); PG8_MMA(0, 1, At, B1); PG8_BAR;
            PG8_LDA(At, 0, 1); PG8_STAGE(PG8_SA(0, 0), a2, voffA);
            PG8_BAR; PG8_WAIT_L(0); PG8_MMA(1, 0, At, B0); PG8_BAR; PG8_SCHED;
            PG8_STAGE(PG8_SB(0, 1), b2 + hstep, voffB);
            PG8_WAIT_V(6); PG8_BAR; PG8_MMA(1, 1, At, B1); PG8_BAR;
            PG8_LDB(B0, 1, 0); PG8_SCHED; PG8_LDA(At, 1, 0); PG8_STAGE(PG8_SA(0, 1), a2 + hstep, voffA);
            PG8_WAIT_L(8); PG8_BAR; PG8_WAIT_L(0); PG8_MMA(0, 0, At, B0); PG8_BAR; PG8_SCHED;
            PG8_LDB(B1, 1, 1); PG8_STAGE(PG8_SB(1, 0), b3, voffB);
            PG8_BAR; PG8_WAIT_L(0); PG8_MMA(0, 1, At, B1); PG8_BAR;
            PG8_LDA(At, 1, 1); PG8_STAGE(PG8_SA(1, 0), a3, voffA);
            PG8_BAR; PG8_WAIT_L(0); PG8_MMA(1, 0, At, B0); PG8_BAR; PG8_SCHED;
            PG8_STAGE(PG8_SB(1, 1), b3 + hstep, voffB);
            PG8_WAIT_V(6); PG8_BAR; PG8_MMA(1, 1, At, B1); PG8_BAR;
            }
        }
        if constexpr (ALIGN_EPI) { if (wr == 0) PG8_BAR; }
        if constexpr (!Epi::AFTER_DRAIN) { E(acc, cur, wr, wc, fr, fq); S.done(cur); }
        if (!has_next) break;
#pragma unroll
        for (int a = 0; a < 2; ++a)
#pragma unroll
            for (int b = 0; b < 2; ++b)
#pragma unroll
                for (int m = 0; m < 4; ++m)
#pragma unroll
                    for (int n = 0; n < 2; ++n) acc[a][b][m][n] = (f32x4){0.f, 0.f, 0.f, 0.f};
        cur = nxt; cA = nA; cB = nB; ++ui;
        if constexpr (ALIGN_EPI) { if (wr == 1) PG8_BAR; }
    }
    PG8_WAIT_V(0);
    if constexpr (!ALIGN_EPI) { if (wr == 0) PG8_BAR; }
    PG8_BAR;
    if constexpr (Epi::AFTER_DRAIN) { E.fused(acc, cur, wr, wc, fr, fq, lds, wid, lane); S.done(cur); }
#undef PG8_SA
#undef PG8_SB
#undef PG8_STAGE
#undef PG8_LDA
#undef PG8_LDB
#undef PG8_MMA
#undef PG8_WAIT_V
#undef PG8_WAIT_L
#undef PG8_BAR
#undef PG8_SCHED
}
}
#define LAS __attribute__((address_space(3)))
typedef unsigned short bf16_t;
typedef short bf16x8 __attribute__((ext_vector_type(8)));
typedef short s16x4 __attribute__((ext_vector_type(4)));
typedef float f32x4 __attribute__((ext_vector_type(4)));
typedef float f32x16 __attribute__((ext_vector_type(16)));
typedef unsigned u32x4 __attribute__((ext_vector_type(4)));
typedef unsigned u32x2 __attribute__((ext_vector_type(2)));
using pg8::cvt_pk_bf16;
constexpr int NB = 8, SEQ = 8192, D = 1024, M = NB * SEQ, INW = 2304, FF = 2816, GU = 2 * FF, DEPTH = 4, NMOD = 6144;
constexpr float EPS = 1e-6f;
constexpr size_t MiB = 1u << 20;
constexpr size_t WS_MOD = 0;
constexpr size_t WS_WSB = 1 * MiB;
constexpr size_t WS_WPB = WS_WSB + 512 * 1024;
constexpr size_t WS_W = 2 * MiB;
constexpr size_t W_IN_OFF = 0, W_OUT_OFF = 5 * MiB, W_GU_OFF = 7 * MiB, W_DN_OFF = 18 * MiB, W_LAYER = 23 * MiB + 512 * 1024;
constexpr size_t WS_H = 96 * MiB;
constexpr size_t WS_P = 224 * MiB;
constexpr size_t WS_END = 576 * MiB;
constexpr size_t WS_SHW1 = 577 * MiB;
constexpr size_t WS_SHW2 = 578 * MiB;
constexpr size_t WS_RSQA = 579 * MiB, WS_RSQB = 579 * MiB + 512 * 1024;
constexpr size_t WS_XS2 = 580 * MiB;
constexpr size_t WS_END2 = 708 * MiB;
constexpr size_t WS_GST = 576 * MiB + 512 * 1024;
constexpr size_t WS_BAR = WS_END;
static_assert(WS_W + 4 * W_LAYER <= WS_H && WS_H + (size_t)M * D * 2 <= WS_P && WS_P + (size_t)M * FF * 2 <= WS_END, "ws map");
constexpr int LDS_BYTES = 147456;
constexpr int NTHREADS = 512;

__device__ __forceinline__ void grid_bar(unsigned* ctr, unsigned& target) {
    target += gridDim.x;
    asm volatile("s_waitcnt vmcnt(0)" ::: "memory");
    __syncthreads();
    if (threadIdx.x == 0) {
        __builtin_amdgcn_fence(__ATOMIC_RELEASE, "agent");
        asm volatile("s_waitcnt vmcnt(0)" ::: "memory");
        __hip_atomic_fetch_add(ctr, 1u, __ATOMIC_RELAXED, __HIP_MEMORY_SCOPE_AGENT);
        while (__hip_atomic_load(ctr, __ATOMIC_RELAXED, __HIP_MEMORY_SCOPE_AGENT) < target) __builtin_amdgcn_s_sleep(1);
        __builtin_amdgcn_fence(__ATOMIC_ACQUIRE, "agent");
        asm volatile("s_waitcnt vmcnt(0)" ::: "memory");
    }
    __syncthreads();
}
struct Args { const float* in[17]; float* out; unsigned char* ws; int ph_lo, ph_hi; };

__device__ __forceinline__ float wave_sum(float v) {
#pragma unroll
    for (int o = 1; o < 64; o <<= 1) v += __shfl_xor(v, o);
    return v;
}
__device__ __forceinline__ float bf2f(unsigned short b) { return __uint_as_float((unsigned)b << 16); }
__device__ __forceinline__ float bflo(unsigned w) { return __uint_as_float(w << 16); }
__device__ __forceinline__ float bfhi(unsigned w) { return __uint_as_float(w & 0xffff0000u); }
__device__ __forceinline__ int crow(int reg, int h) { return (reg & 3) + 8 * (reg >> 2) + 4 * h; }
#define MFMA32(a, b, c) __builtin_amdgcn_mfma_f32_32x32x16_bf16((a), (b), (c), 0, 0, 0)
typedef short v4i16_t __attribute__((ext_vector_type(4)));
__device__ __forceinline__ s16x4 vtr(LAS const unsigned char* p) { return __builtin_bit_cast(s16x4, __builtin_amdgcn_ds_read_tr16_b64_v4i16((LAS v4i16_t*)p)); }
__device__ __forceinline__ bf16x8 cat8(s16x4 lo, s16x4 hi) { return __builtin_shufflevector(lo, hi, 0, 1, 2, 3, 4, 5, 6, 7); }

__device__ __forceinline__ void phase_pro(const Args& a, LAS unsigned char* lds) {
    const int tid = opaque_tid(), G = gridDim.x, bid = opaque_bid();
    LAS float* sc = (LAS float*)lds; LAS float* red = (LAS float*)(lds + 32768);
    { const float* c = a.in[1];
      for (int i = tid; i < NB * D; i += NTHREADS) { const float v = c[i]; sc[i] = v * pg8::fast_sigmoid(v); } }
    __syncthreads();
    float* mod = (float*)(a.ws + WS_MOD);
    if (MK_PRO_MASK & 1)
    for (int item = bid; item < DEPTH * 192; item += G) {
        const int l = item / 192, cgp = item % 192, kp = tid >> 3, n4 = tid & 7;
        float acc[8][4];
#pragma unroll
        for (int b = 0; b < 8; ++b)
#pragma unroll
            for (int j = 0; j < 4; ++j) acc[b][j] = 0.f;
        const float* wp = a.in[2] + ((size_t)l * D + kp * 16) * NMOD + cgp * 32 + n4 * 4;
#pragma unroll 4
        for (int k = 0; k < 16; ++k) {
            const f32x4 w = *(const f32x4*)(wp + (size_t)k * NMOD);
#pragma unroll
            for (int b = 0; b < 8; ++b) { const float s = sc[b * D + kp * 16 + k]; acc[b][0] += s * w[0]; acc[b][1] += s * w[1]; acc[b][2] += s * w[2]; acc[b][3] += s * w[3]; }
        }
#pragma unroll
        for (int b = 0; b < 8; ++b)
#pragma unroll
            for (int j = 0; j < 4; ++j) red[(kp * 8 + b) * 32 + n4 * 4 + j] = acc[b][j];
        __syncthreads();
        if (tid < 256) { const int b = tid >> 5, col = tid & 31; float s = 0.f;
            for (int k2 = 0; k2 < 64; ++k2) s += red[(k2 * 8 + b) * 32 + col];
            mod[(size_t)(l * 8 + b) * NMOD + cgp * 32 + col] = s + a.in[3][l * NMOD + cgp * 32 + col]; }
        __syncthreads();
    }
    LAS float* tile = (LAS float*)lds;
    if (MK_PRO_MASK & 2)
    for (int it = bid; it < DEPTH * 2944; it += G) {
        const int l = it / 2944; int r = it % 2944;
        const float* W; int K, N, kt, nt, kind = 0; size_t woff;
        if (r < 576) { W = a.in[5] + (size_t)l * D * INW; K = D; N = INW; kt = r / 36; nt = r % 36; woff = W_IN_OFF; }
        else if (r < 832) { r -= 576; W = a.in[12] + (size_t)l * D * D; K = D; N = D; kt = r / 16; nt = r % 16; woff = W_OUT_OFF; }
        else if (r < 2240) { r -= 832; W = a.in[14] + (size_t)l * D * GU; K = D; N = GU; kt = r / 88; nt = r % 88; woff = W_GU_OFF; kind = 1; }
        else { r -= 2240; W = a.in[15] + (size_t)l * FF * D; K = FF; N = D; kt = r / 16; nt = r % 16; woff = W_DN_OFF; }
        bf16_t* WT = (bf16_t*)(a.ws + WS_W + (size_t)l * W_LAYER + woff);
        const int n0 = nt * 64, k0 = kt * 64;
        int dn0 = n0;
        if (kind == 1) { dn0 = n0 < FF ? (n0 / 128) * 256 + (n0 % 128) : ((n0 - FF) / 128) * 256 + 128 + ((n0 - FF) % 128); }
#pragma unroll
        for (int p = 0; p < 2; ++p) { const int row = (tid >> 4) + 32 * p, c4 = tid & 15;
            const f32x4 v = *(const f32x4*)(W + (size_t)(k0 + row) * N + n0 + 4 * c4);
            tile[row * 65 + 4 * c4 + 0] = v[0]; tile[row * 65 + 4 * c4 + 1] = v[1]; tile[row * 65 + 4 * c4 + 2] = v[2]; tile[row * 65 + 4 * c4 + 3] = v[3]; }
        __syncthreads();
        { const int n = tid >> 3, kc = tid & 7; LAS const float* s = tile + (8 * kc) * 65 + n;
          u32x4 o; o.x = cvt_pk_bf16(s[0], s[65]); o.y = cvt_pk_bf16(s[2 * 65], s[3 * 65]); o.z = cvt_pk_bf16(s[4 * 65], s[5 * 65]); o.w = cvt_pk_bf16(s[6 * 65], s[7 * 65]);
          *(u32x4*)(WT + (size_t)(dn0 + n) * K + k0 + 8 * kc) = o; }
        __syncthreads();
    }
    if (MK_PRO_MASK & 4)
    { const float* ws_ = a.in[9]; bf16_t* wsb = (bf16_t*)(a.ws + WS_WSB);
      for (int i = bid * NTHREADS + tid; i < DEPTH * 4 * 128 * 128; i += G * NTHREADS) { const int s = i & 127, t = (i >> 7) & 127; const float v = (s <= t) ? ws_[i] : 0.f; wsb[i] = (bf16_t)(cvt_pk_bf16(v, 0.f) & 0xffffu); }
      const float* wp_ = a.in[6]; bf16_t* wpb = (bf16_t*)(a.ws + WS_WPB);
      for (int i = bid * NTHREADS + tid; i < DEPTH * 4 * 64 * 64; i += G * NTHREADS) { const int c = i & 63, e = (i >> 6) & 63, lg = i >> 12; wpb[i] = (bf16_t)(cvt_pk_bf16(wp_[(lg * 64 + c) * 64 + e], 0.f) & 0xffffu); } }
}

__device__ __forceinline__ void phase_pro2(const Args& a) {
    const int tid = opaque_tid(), lane = tid & 63, wave = tid >> 6, gw = opaque_bid() * 8 + wave, NGW = gridDim.x * 8;
    const int pair = gw & 7, l = pair >> 1, which = pair & 1, N = which ? GU : INW;
    const float* sh = (const float*)(a.ws + WS_MOD) + (size_t)l * 8 * NMOD + (which ? 3072 : 0);
    const bf16_t* WT = (const bf16_t*)(a.ws + WS_W + (size_t)l * W_LAYER + (which ? W_GU_OFF : W_IN_OFF));
    float* out = (float*)(a.ws + (which ? WS_SHW2 : WS_SHW1)) + (size_t)l * 8 * N;
    f32x4 sv[8][4];
#pragma unroll
    for (int b = 0; b < 8; ++b)
#pragma unroll
        for (int j = 0; j < 4; ++j) sv[b][j] = *(const f32x4*)(sh + (size_t)b * NMOD + 16 * lane + 4 * j);
    for (int n = gw >> 3; n < N; n += NGW >> 3) {
        const u32x4 w0 = *(const u32x4*)(WT + (size_t)n * D + 16 * lane), w1 = *(const u32x4*)(WT + (size_t)n * D + 16 * lane + 8);
        const f32x4 f0 = {bflo(w0.x), bfhi(w0.x), bflo(w0.y), bfhi(w0.y)}, f1 = {bflo(w0.z), bfhi(w0.z), bflo(w0.w), bfhi(w0.w)};
        const f32x4 f2 = {bflo(w1.x), bfhi(w1.x), bflo(w1.y), bfhi(w1.y)}, f3 = {bflo(w1.z), bfhi(w1.z), bflo(w1.w), bfhi(w1.w)};
        float r[8];
#pragma unroll
        for (int b = 0; b < 8; ++b) { const f32x4 p = sv[b][0] * f0 + sv[b][1] * f1 + sv[b][2] * f2 + sv[b][3] * f3; r[b] = wave_sum((p[0] + p[1]) + (p[2] + p[3])); }
        if (lane == 0) {
#pragma unroll
            for (int b = 0; b < 8; ++b) out[(size_t)b * N + n] = r[b]; }
    }
}
__device__ __forceinline__ void phase_gst(const Args& a) {
    const float* mod = (const float*)(a.ws + WS_MOD); float* gst = (float*)(a.ws + WS_GST);
    for (int i = opaque_bid() * NTHREADS + opaque_tid(); i < DEPTH * 2 * 8 * D; i += gridDim.x * NTHREADS) {
        const int k = i & 1023, b = (i >> 10) & 7, which = (i >> 13) & 1, l = i >> 14;
        gst[i] = a.in[which ? 13 : 4][l * D + k] * (1.0f + mod[(size_t)(l * 8 + b) * NMOD + (which ? 4096 : 1024) + k]); }
}
__device__ __forceinline__ void zero_rows(float* p) {
    for (int i = opaque_bid() * NTHREADS + opaque_tid(); i < M; i += gridDim.x * NTHREADS) p[i] = 0.f;
}

__device__ __forceinline__ void phase_norm(const float* xin, const float* g, const float* sh, const float* sc, bf16_t* hout) {
    const int tid = opaque_tid(), lane = tid & 63, wave = tid >> 6, gw = opaque_bid() * 8 + wave, NGW = gridDim.x * 8;
    const int b = gw & 7, r0 = gw >> 3, rstep = NGW >> 3;
    f32x4 gs[4], sv[4];
#pragma unroll
    for (int j = 0; j < 4; ++j) { const int col = 4 * lane + 256 * j; const f32x4 gg = *(const f32x4*)(g + col), ss = *(const f32x4*)(sc + (size_t)b * NMOD + col);
        gs[j] = gg * (ss + 1.0f); sv[j] = *(const f32x4*)(sh + (size_t)b * NMOD + col); }
    for (int r = r0; r < SEQ; r += rstep) {
        const size_t row = (size_t)b * SEQ + r; const f32x4* xr = (const f32x4*)(xin + row * D) + lane;
        f32x4 v[4]; float s = 0.f;
#pragma unroll
        for (int j = 0; j < 4; ++j) { v[j] = xr[64 * j]; s += (v[j][0] * v[j][0] + v[j][1] * v[j][1]) + (v[j][2] * v[j][2] + v[j][3] * v[j][3]); }
        const float rstd = __builtin_amdgcn_rsqf(wave_sum(s) * (1.0f / D) + EPS);
        u32x2* o = (u32x2*)(hout + row * D) + lane;
#pragma unroll
        for (int j = 0; j < 4; ++j) { const f32x4 y = v[j] * rstd * gs[j] + sv[j]; u32x2 w; w.x = cvt_pk_bf16(y[0], y[1]); w.y = cvt_pk_bf16(y[2], y[3]); o[64 * j] = w; }
    }
}
__device__ __forceinline__ void phase_final(const float* xin, const float* g, float* out) {
    const int tid = opaque_tid(), lane = tid & 63, wave = tid >> 6, gw = opaque_bid() * 8 + wave, NGW = gridDim.x * 8;
    f32x4 gs[4];
#pragma unroll
    for (int j = 0; j < 4; ++j) gs[j] = *(const f32x4*)(g + 4 * lane + 256 * j);
    for (int row = gw; row < M; row += NGW) {
        const f32x4* xr = (const f32x4*)(xin + (size_t)row * D) + lane; f32x4 v[4]; float s = 0.f;
#pragma unroll
        for (int j = 0; j < 4; ++j) { v[j] = xr[64 * j]; s += (v[j][0] * v[j][0] + v[j][1] * v[j][1]) + (v[j][2] * v[j][2] + v[j][3] * v[j][3]); }
        const float rstd = __builtin_amdgcn_rsqf(wave_sum(s) * (1.0f / D) + EPS);
        f32x4* o = (f32x4*)(out + (size_t)row * D) + lane;
#pragma unroll
        for (int j = 0; j < 4; ++j) o[64 * j] = v[j] * rstd * gs[j];
    }
}
__device__ __forceinline__ void attn_unit(int unit, const bf16_t* proj, bf16_t* merged, const float* mn, LAS unsigned char* lds, int wave, int lane) {
    const int b = unit >> 8, q0 = (unit & 255) * 32, n = lane & 31, h = lane >> 5, hd = wave;
    const size_t rowbase = (size_t)b * SEQ;
    constexpr float C1 = 0.125f * 1.4426950408889634f;
    bf16x8 bq[4];
    { const bf16_t* qp = proj + (rowbase + q0 + n) * INW + hd * 64 + 8 * h;
#pragma unroll
      for (int s = 0; s < 4; ++s) bq[s] = *(const bf16x8*)(qp + 16 * s); }
    f32x16 o0, o1;
#pragma unroll
    for (int i = 0; i < 16; ++i) { o0[i] = 0.f; o1[i] = 0.f; }
    float carry = 1.f;
    LAS unsigned char* kl = lds + wave * 9216; LAS unsigned char* vl = kl + 4608;
    const int nkt = min(17, (q0 >> 5) + 1);
    const int q4 = (lane & 15) >> 2, p4 = lane & 3, blk = (lane >> 4) & 1;
    u32x4 kv[4], vv[4];
    const bf16_t* kp = proj + (rowbase + q0) * INW + 512 + hd * 64 + (size_t)(lane >> 3) * INW + (lane & 7) * 8;
#pragma unroll
    for (int i = 0; i < 4; ++i) { kv[i] = *(const u32x4*)(kp + (size_t)(8 * i) * INW); vv[i] = *(const u32x4*)(kp + 512 + (size_t)(8 * i) * INW); }
    for (int kt = 0; kt < nkt; ++kt) {
#pragma unroll
        for (int i = 0; i < 4; ++i) { const int c = lane + 64 * i, row = c >> 3, ch = c & 7; *(LAS u32x4*)(kl + row * 144 + ch * 16) = kv[i]; *(LAS u32x4*)(vl + row * 144 + ch * 16) = vv[i]; }
        if (kt + 1 < nkt) { kp -= (size_t)32 * INW;
#pragma unroll
            for (int i = 0; i < 4; ++i) { kv[i] = *(const u32x4*)(kp + (size_t)(8 * i) * INW); vv[i] = *(const u32x4*)(kp + 512 + (size_t)(8 * i) * INW); } }
        asm volatile("s_waitcnt lgkmcnt(0)" ::: "memory");
        f32x16 st;
#pragma unroll
        for (int i = 0; i < 16; ++i) st[i] = 0.f;
#pragma unroll
        for (int s = 0; s < 4; ++s) { const bf16x8 ka = *(LAS const bf16x8*)(kl + n * 144 + (2 * s + h) * 16); st = MFMA32(ka, bq[s], st); }
        float be[16], om[16], w[16];
#pragma unroll
        for (int i = 0; i < 16; ++i) {
            const float e = __builtin_amdgcn_exp2f(fminf(st[i] * (-C1), 80.f));
            be[i] = __builtin_amdgcn_rcpf(1.0f + e);
            om[i] = e * be[i];
        }
        if (kt == 0 || kt == 16) {
#pragma unroll
            for (int i = 0; i < 16; ++i) { const bool valid = (kt == 0) ? (crow(i, h) < n) : (crow(i, h) >= n); be[i] = valid ? be[i] : 0.f; om[i] = valid ? om[i] : 1.f; }
        }
        const float G0 = (om[0] * om[1]) * (om[2] * om[3]), G1 = (om[4] * om[5]) * (om[6] * om[7]), G2 = (om[8] * om[9]) * (om[10] * om[11]), G3 = (om[12] * om[13]) * (om[14] * om[15]);
        const float P0 = __shfl_xor(G0, 32), P1 = __shfl_xor(G1, 32), P2 = __shfl_xor(G2, 32), P3 = __shfl_xor(G3, 32);
        const float S2 = G3 * P3, S1 = S2 * (G2 * P2), S0 = S1 * (G1 * P1), tot = S0 * (G0 * P0);
        float T[4]; T[0] = S0 * (h == 0 ? P0 : 1.f); T[1] = S1 * (h == 0 ? P1 : 1.f); T[2] = S2 * (h == 0 ? P2 : 1.f); T[3] = (h == 0 ? P3 : 1.f);
#pragma unroll
        for (int g = 0; g < 4; ++g) {
            float later = carry * T[g];
#pragma unroll
            for (int j = 3; j >= 0; --j) { const int i = 4 * g + j; w[i] = be[i] * later; later *= om[i]; }
        }
        carry *= tot;
        const bool done = __builtin_amdgcn_ballot_w64(carry >= 1e-20f) == 0ull;
        bf16x8 wf[2];
#pragma unroll
        for (int s = 0; s < 2; ++s) { u32x4 p; p.x = cvt_pk_bf16(w[8 * s], w[8 * s + 1]); p.y = cvt_pk_bf16(w[8 * s + 2], w[8 * s + 3]); p.z = cvt_pk_bf16(w[8 * s + 4], w[8 * s + 5]); p.w = cvt_pk_bf16(w[8 * s + 6], w[8 * s + 7]); wf[s] = __builtin_bit_cast(bf16x8, p); }
#pragma unroll
        for (int s = 0; s < 2; ++s) {
            LAS const unsigned char* vb = vl + (16 * s + 4 * h + q4) * 144 + 32 * blk + 8 * p4;
            const s16x4 lo0 = vtr(vb), hi0 = vtr(vb + 8 * 144), lo1 = vtr(vb + 64), hi1 = vtr(vb + 8 * 144 + 64);
            o0 = MFMA32(cat8(lo0, hi0), wf[s], o0);
            o1 = MFMA32(cat8(lo1, hi1), wf[s], o1);
        }
        asm volatile("" ::: "memory");
        if (done) break;
    }
    float ss = 0.f;
#pragma unroll
    for (int i = 0; i < 16; ++i) ss += o0[i] * o0[i] + o1[i] * o1[i];
    ss += __shfl_xor(ss, 32);
    LAS float* ex = (LAS float*)(lds + 73728);
    if (h == 0) ex[wave * 32 + n] = ss;
    __syncthreads();
    float tot = 0.f;
#pragma unroll
    for (int w8 = 0; w8 < 8; ++w8) tot += ex[w8 * 32 + n];
    const float rstd = __builtin_amdgcn_rsqf(tot * (1.0f / 512.0f) + EPS);
    bf16_t* op = merged + (rowbase + q0 + n) * D + hd * 64 + 4 * h;
    const float* mp = mn + hd * 64 + 4 * h;
#pragma unroll
    for (int g = 0; g < 4; ++g) {
        const f32x4 m0 = *(const f32x4*)(mp + 8 * g), m1 = *(const f32x4*)(mp + 32 + 8 * g);
        u32x2 a0, a1;
        a0.x = cvt_pk_bf16(o0[4 * g] * rstd * m0[0], o0[4 * g + 1] * rstd * m0[1]); a0.y = cvt_pk_bf16(o0[4 * g + 2] * rstd * m0[2], o0[4 * g + 3] * rstd * m0[3]);
        a1.x = cvt_pk_bf16(o1[4 * g] * rstd * m1[0], o1[4 * g + 1] * rstd * m1[1]); a1.y = cvt_pk_bf16(o1[4 * g + 2] * rstd * m1[2], o1[4 * g + 3] * rstd * m1[3]);
        *(u32x2*)(op + 8 * g) = a0; *(u32x2*)(op + 32 + 8 * g) = a1;
    }
    __syncthreads();
}

__device__ __forceinline__ void sg_unit(int unit, const bf16_t* proj, bf16_t* merged, const float* mn, const float* sgn, const bf16_t* wsb, const float* bs, LAS unsigned char* lds, int tid, int wave, int lane) {
    const size_t R0 = (size_t)unit * 128;
    constexpr int RS = 528;
    { const int t = tid >> 2, part = tid & 3;
      const bf16_t* vp = proj + (R0 + t) * INW + 2048 + 64 * part;
      u32x4 raw[8];
#pragma unroll
      for (int i = 0; i < 8; ++i) raw[i] = *(const u32x4*)(vp + 8 * i);
      float s = 0.f;
#pragma unroll
      for (int i = 0; i < 8; ++i) s += (bflo(raw[i].x) + bfhi(raw[i].x)) + (bflo(raw[i].y) + bfhi(raw[i].y)) + (bflo(raw[i].z) + bfhi(raw[i].z)) + (bflo(raw[i].w) + bfhi(raw[i].w));
      s += __shfl_xor(s, 1); s += __shfl_xor(s, 2);
      const float mean = s * (1.0f / 256.0f);
      float q = 0.f;
#pragma unroll
      for (int i = 0; i < 8; ++i) { float d;
          d = bflo(raw[i].x) - mean; q += d * d; d = bfhi(raw[i].x) - mean; q += d * d; d = bflo(raw[i].y) - mean; q += d * d; d = bfhi(raw[i].y) - mean; q += d * d;
          d = bflo(raw[i].z) - mean; q += d * d; d = bfhi(raw[i].z) - mean; q += d * d; d = bflo(raw[i].w) - mean; q += d * d; d = bfhi(raw[i].w) - mean; q += d * d; }
      q += __shfl_xor(q, 1); q += __shfl_xor(q, 2);
      const float rstd = __builtin_amdgcn_rsqf(q * (1.0f / 256.0f) + EPS);
      const float* gp = sgn + 64 * part;
#pragma unroll
      for (int i = 0; i < 8; ++i) { const f32x4 ga = *(const f32x4*)(gp + 8 * i), gb = *(const f32x4*)(gp + 8 * i + 4); u32x4 o;
          o.x = cvt_pk_bf16((bflo(raw[i].x) - mean) * rstd * ga[0], (bfhi(raw[i].x) - mean) * rstd * ga[1]); o.y = cvt_pk_bf16((bflo(raw[i].y) - mean) * rstd * ga[2], (bfhi(raw[i].y) - mean) * rstd * ga[3]);
          o.z = cvt_pk_bf16((bflo(raw[i].z) - mean) * rstd * gb[0], (bfhi(raw[i].z) - mean) * rstd * gb[1]); o.w = cvt_pk_bf16((bflo(raw[i].w) - mean) * rstd * gb[2], (bfhi(raw[i].w) - mean) * rstd * gb[3]);
          *(LAS u32x4*)(lds + t * RS + 2 * (64 * part + 8 * i)) = o; }
    }
    __syncthreads();
    const int h4 = wave >> 1, dh = wave & 1, n = lane & 31, h = lane >> 5, cbase = 64 * h4 + 32 * dh;
    const int q4 = (lane & 15) >> 2, p4 = lane & 3, blk = (lane >> 4) & 1;
    f32x16 acc[4];
#pragma unroll
    for (int tt = 0; tt < 4; ++tt)
#pragma unroll
        for (int i = 0; i < 16; ++i) acc[tt][i] = 0.f;
#pragma unroll
    for (int ks = 0; ks < 8; ++ks) {
        LAS const unsigned char* vb = lds + (16 * ks + 8 * h + q4) * RS + 2 * (cbase + 16 * blk) + 8 * p4;
        const bf16x8 af = cat8(vtr(vb), vtr(vb + 4 * RS));
#pragma unroll
        for (int tt = 0; tt < 4; ++tt) if (ks < 2 * (tt + 1)) {
            const bf16x8 bfr = *(const bf16x8*)(wsb + (size_t)(h4 * 128 + 32 * tt + n) * 128 + 16 * ks + 8 * h);
            acc[tt] = MFMA32(af, bfr, acc[tt]); }
    }
    LAS float* ex = (LAS float*)(lds + 67584);
#pragma unroll
    for (int tt = 0; tt < 4; ++tt) { const int t = 32 * tt + n; const float bias = bs[h4 * 128 + t]; const bf16_t* up = proj + (R0 + t) * INW + 1792 + cbase + 4 * h; float s = 0.f;
#pragma unroll
        for (int g = 0; g < 4; ++g) { const u32x2 uu = *(const u32x2*)(up + 8 * g);
            const float v0 = bflo(uu.x) * (acc[tt][4 * g] + bias), v1 = bfhi(uu.x) * (acc[tt][4 * g + 1] + bias), v2 = bflo(uu.y) * (acc[tt][4 * g + 2] + bias), v3 = bfhi(uu.y) * (acc[tt][4 * g + 3] + bias);
            acc[tt][4 * g] = v0; acc[tt][4 * g + 1] = v1; acc[tt][4 * g + 2] = v2; acc[tt][4 * g + 3] = v3; s += (v0 * v0 + v1 * v1) + (v2 * v2 + v3 * v3); }
        s += __shfl_xor(s, 32);
        if (h == 0) ex[wave * 128 + t] = s; }
    __syncthreads();
#pragma unroll
    for (int tt = 0; tt < 4; ++tt) { const int t = 32 * tt + n; float tot = 0.f;
#pragma unroll
        for (int w8 = 0; w8 < 8; ++w8) tot += ex[w8 * 128 + t];
        const float rstd = __builtin_amdgcn_rsqf(tot * (1.0f / 256.0f) + EPS);
        bf16_t* op = merged + (R0 + t) * D + 768 + cbase + 4 * h; const float* mp = mn + 768 + cbase + 4 * h;
#pragma unroll
        for (int g = 0; g < 4; ++g) { const f32x4 m0 = *(const f32x4*)(mp + 8 * g); u32x2 a0;
            a0.x = cvt_pk_bf16(acc[tt][4 * g] * rstd * m0[0], acc[tt][4 * g + 1] * rstd * m0[1]); a0.y = cvt_pk_bf16(acc[tt][4 * g + 2] * rstd * m0[2], acc[tt][4 * g + 3] * rstd * m0[3]);
            *(u32x2*)(op + 8 * g) = a0; } }
    __syncthreads();
}

__device__ __forceinline__ void pool_unit(int unit, const bf16_t* proj, bf16_t* merged, const float* mn, const bf16_t* wpb, const float* pscale, LAS unsigned char* lds, int tid, int wave, int lane) {
    const size_t T0 = (size_t)unit * 128; const int pos0 = (unit & 63) * 128;
    constexpr int RS = 528;
    for (int c = tid; c < 144 * 32; c += NTHREADS) { const int li = c >> 5, ch = c & 31; u32x4 v = (u32x4){0u, 0u, 0u, 0u};
        if (li >= 16 || pos0 > 0) v = *(const u32x4*)(proj + (T0 + li - 16) * INW + 1536 + 8 * ch);
        *(LAS u32x4*)(lds + li * RS + 16 * ch) = v; }
    __syncthreads();
    const int g = wave >> 1, ttp = wave & 1, n = lane & 31, h = lane >> 5, W = 2 << g;
    f32x16 acc[2][2];
#pragma unroll
    for (int a = 0; a < 2; ++a)
#pragma unroll
        for (int e2 = 0; e2 < 2; ++e2)
#pragma unroll
            for (int i = 0; i < 16; ++i) acc[a][e2][i] = 0.f;
    bf16x8 af[2][4];
#pragma unroll
    for (int e2 = 0; e2 < 2; ++e2)
#pragma unroll
        for (int ks = 0; ks < 4; ++ks) af[e2][ks] = *(const bf16x8*)(wpb + (size_t)(g * 64 + 32 * e2 + n) * 64 + 16 * ks + 8 * h);
#pragma unroll
    for (int a = 0; a < 2; ++a) {
        const int tt = 2 * ttp + a, li = 16 + 32 * tt + n, pos = pos0 + 32 * tt + n; const float inv = 1.0f / (float)min(pos + 1, W);
#pragma unroll
        for (int ks = 0; ks < 4; ++ks) {
            LAS const unsigned char* pb = lds + li * RS + 2 * (64 * g + 16 * ks + 8 * h);
            float sm[8];
#pragma unroll
            for (int k = 0; k < 8; ++k) sm[k] = 0.f;
            for (int j = 0; j < W; ++j) { const u32x4 v = *(LAS const u32x4*)(pb - j * RS);
                sm[0] += bflo(v.x); sm[1] += bfhi(v.x); sm[2] += bflo(v.y); sm[3] += bfhi(v.y); sm[4] += bflo(v.z); sm[5] += bfhi(v.z); sm[6] += bflo(v.w); sm[7] += bfhi(v.w); }
            const u32x4 own = *(LAS const u32x4*)pb; u32x4 p;
            p.x = cvt_pk_bf16(sm[0] * inv - bflo(own.x), sm[1] * inv - bfhi(own.x)); p.y = cvt_pk_bf16(sm[2] * inv - bflo(own.y), sm[3] * inv - bfhi(own.y));
            p.z = cvt_pk_bf16(sm[4] * inv - bflo(own.z), sm[5] * inv - bfhi(own.z)); p.w = cvt_pk_bf16(sm[6] * inv - bflo(own.w), sm[7] * inv - bfhi(own.w));
            const bf16x8 pf = __builtin_bit_cast(bf16x8, p);
            acc[a][0] = MFMA32(af[0][ks], pf, acc[a][0]);
            acc[a][1] = MFMA32(af[1][ks], pf, acc[a][1]);
        }
    }
    LAS float* ex = (LAS float*)(lds + 76032);
#pragma unroll
    for (int a = 0; a < 2; ++a) { float s = 0.f;
#pragma unroll
        for (int e2 = 0; e2 < 2; ++e2)
#pragma unroll
            for (int gg = 0; gg < 4; ++gg) { const f32x4 ps = *(const f32x4*)(pscale + 64 * g + 32 * e2 + 4 * h + 8 * gg);
#pragma unroll
                for (int j = 0; j < 4; ++j) { const float v = acc[a][e2][4 * gg + j] * ps[j]; acc[a][e2][4 * gg + j] = v; s += v * v; } }
        s += __shfl_xor(s, 32);
        if (h == 0) ex[g * 128 + 32 * (2 * ttp + a) + n] = s; }
    __syncthreads();
#pragma unroll
    for (int a = 0; a < 2; ++a) { const int t = 32 * (2 * ttp + a) + n;
        const float tot = (ex[t] + ex[128 + t]) + (ex[256 + t] + ex[384 + t]);
        const float rstd = __builtin_amdgcn_rsqf(tot * (1.0f / 256.0f) + EPS);
#pragma unroll
        for (int e2 = 0; e2 < 2; ++e2) { const int ebase = 64 * g + 32 * e2 + 4 * h;
            bf16_t* op = merged + (T0 + t) * D + 512 + ebase; const float* mp = mn + 512 + ebase;
#pragma unroll
            for (int gg = 0; gg < 4; ++gg) { const f32x4 m0 = *(const f32x4*)(mp + 8 * gg); u32x2 a0;
                a0.x = cvt_pk_bf16(acc[a][e2][4 * gg] * rstd * m0[0], acc[a][e2][4 * gg + 1] * rstd * m0[1]); a0.y = cvt_pk_bf16(acc[a][e2][4 * gg + 2] * rstd * m0[2], acc[a][e2][4 * gg + 3] * rstd * m0[3]);
                *(u32x2*)(op + 8 * gg) = a0; } } }
    __syncthreads();
}

__device__ __forceinline__ void phase_mix(const Args& a, int l, LAS unsigned char* lds) {
    const int tid = opaque_tid(), lane = tid & 63, wave = __builtin_amdgcn_readfirstlane(tid >> 6), G = gridDim.x, bid = opaque_bid();
    const bf16_t* proj = (const bf16_t*)(a.ws + WS_P); bf16_t* merged = (bf16_t*)(a.ws + WS_H);
    const float* mn = a.in[11] + (size_t)l * D;
    { const int per = (M / 32 + G - 1) / G;
      for (int u = bid * per; u < min(M / 32, (bid + 1) * per); ++u) attn_unit(u, proj, merged, mn, lds, wave, lane); }
    { const float* sgn = a.in[8] + l * 256; const bf16_t* wsb = (const bf16_t*)(a.ws + WS_WSB) + (size_t)l * 4 * 128 * 128; const float* bs = a.in[10] + l * 4 * 128;
      for (int u = bid; u < M / 128; u += G) sg_unit(u, proj, merged, mn, sgn, wsb, bs, lds, tid, wave, lane); }
    { const bf16_t* wpb = (const bf16_t*)(a.ws + WS_WPB) + (size_t)l * 4 * 64 * 64; const float* pscale = a.in[7] + l * 256;
      for (int u = bid; u < M / 128; u += G) pool_unit(u, proj, merged, mn, wpb, pscale, lds, tid, wave, lane); }
}
constexpr int N_STEPS = 3 + 5 * DEPTH;
__global__ void __launch_bounds__(NTHREADS, 2) fwd(Args args) {
    extern __shared__ __attribute__((aligned(16))) unsigned char lds_raw[];
    LAS unsigned char* lds = (LAS unsigned char*)lds_raw;
#if MK_ONE_LAUNCH
#define SEAM() grid_bar(bar_ctr, bar_target)
#define SEAM_CG() do { __syncthreads(); cg::this_grid().sync(); } while (0)
#else
#define SEAM() do { } while (0)
#define SEAM_CG() do { } while (0)
#endif
#define RUN(k) (args.ph_lo <= (k) && (k) < args.ph_hi && (k) < MK_MAX_STEP)
    unsigned char* ws = args.ws;
    const float* mod = (const float*)(ws + WS_MOD);
    bf16_t* hbuf = (bf16_t*)(ws + WS_H); bf16_t* pbuf = (bf16_t*)(ws + WS_P);
    unsigned* bar_ctr = (unsigned*)(ws + WS_BAR); unsigned bar_target = 0u; (void)bar_ctr; (void)bar_target;
    if (RUN(0)) phase_pro(args, lds);
    SEAM_CG();
    bf16_t* xs2 = (bf16_t*)(ws + WS_XS2); float* rsqA = (float*)(ws + WS_RSQA); float* rsqB = (float*)(ws + WS_RSQB);
    if (RUN(1)) { phase_pro2(args); phase_gst(args); phase_norm(args.in[0], args.in[4], mod, mod + 1024, hbuf); }
    SEAM();
#pragma nounroll
    for (int l = 0; l < DEPTH; ++l) {
        const int s0 = 2 + 5 * l;
        const float* xin = (l == 0) ? args.in[0] : args.out;
        const float* modl = mod + (size_t)l * 8 * NMOD;
        const unsigned char* wl = ws + WS_W + (size_t)l * W_LAYER;
        if (RUN(s0 + 0)) { zero_rows(rsqA);
            pg8::Gemm g{hbuf, (const bf16_t*)(wl + W_IN_OFF), M, INW, D}; pg8::StaticOrder S; S.init(M, INW, gridDim.x, opaque_bid());
            pg8::EpiProj E{pbuf, l == 0 ? nullptr : rsqB, (const float*)(ws + WS_SHW1) + (size_t)l * 8 * INW};
            pg8::gemm_phase<pg8::EpiProj, pg8::StaticOrder, true, true>(lds, g, S, E); }
        SEAM();
        if (RUN(s0 + 1)) phase_mix(args, l, lds);
        SEAM();
        if (RUN(s0 + 2)) { pg8::Gemm g{hbuf, (const bf16_t*)(wl + W_OUT_OFF), M, D, D}; pg8::StaticOrder S; S.init(M, D, gridDim.x, opaque_bid());
            pg8::EpiRes E{xin, args.out, modl + 2048, xs2, rsqA, (const float*)(ws + WS_GST) + (size_t)(l * 2 + 1) * 8 * D};
            pg8::gemm_phase<pg8::EpiRes, pg8::StaticOrder, true, true>(lds, g, S, E); }
        SEAM();
        if (RUN(s0 + 3)) { zero_rows(rsqB);
            pg8::Gemm g{xs2, (const bf16_t*)(wl + W_GU_OFF), M, GU, D}; pg8::StaticOrder S; S.init(M, GU, gridDim.x, opaque_bid());
            pg8::EpiSwiglu E{pbuf, rsqA, (const float*)(ws + WS_SHW2) + (size_t)l * 8 * GU};
            pg8::gemm_phase<pg8::EpiSwiglu, pg8::StaticOrder, true, true>(lds, g, S, E); }
        SEAM();
        if (RUN(s0 + 4)) { const bool last = (l == DEPTH - 1); const int ln = last ? l : l + 1;
            pg8::Gemm g{pbuf, (const bf16_t*)(wl + W_DN_OFF), M, D, FF}; pg8::StaticOrder S; S.init(M, D, gridDim.x, opaque_bid());
            pg8::EpiRes E{args.out, args.out, modl + 5120, last ? nullptr : hbuf, rsqB, (const float*)(ws + WS_GST) + (size_t)(ln * 2) * 8 * D};
            pg8::gemm_phase<pg8::EpiRes, pg8::StaticOrder, true, true>(lds, g, S, E); }
        SEAM();
    }
    if (RUN(N_STEPS - 1)) phase_final(args.out, args.in[16], args.out);
#undef RUN
#undef SEAM
#undef SEAM_CG
}

extern "C" void kernel_launch(void* const* d_in, const int* in_sizes, int n_in, void* d_out, int out_size, void* d_ws, size_t ws_size, hipStream_t stream) {
    static int grid = 0;
    if (grid == 0) {
        if (n_in != 17 || in_sizes[0] != M * D || out_size != M * D || ws_size < WS_END2) { fprintf(stderr, "kernel_launch: unexpected shapes (n_in %d in0 %d out %d ws %zu)\n", n_in, n_in > 0 ? in_sizes[0] : -1, out_size, ws_size); grid = -1; return; }
        int dev = 0, cus = 0, per_cu = 0;
        if (hipGetDevice(&dev) != hipSuccess || hipDeviceGetAttribute(&cus, hipDeviceAttributeMultiprocessorCount, dev) != hipSuccess) { grid = -1; return; }
        if (hipFuncSetAttribute((const void*)fwd, hipFuncAttributeMaxDynamicSharedMemorySize, LDS_BYTES) != hipSuccess) { fprintf(stderr, "kernel_launch: hipFuncSetAttribute failed\n"); grid = -1; return; }
        if (hipOccupancyMaxActiveBlocksPerMultiprocessor(&per_cu, (const void*)fwd, NTHREADS, LDS_BYTES) != hipSuccess || per_cu < 1) { fprintf(stderr, "kernel_launch: occupancy query gave %d\n", per_cu); per_cu = 1; }
        (void)hipGetLastError();
        grid = cus * per_cu;
    }
    if (grid < 0) return;
    Args a{};
    for (int i = 0; i < 17; ++i) a.in[i] = (const float*)d_in[i];
    a.out = (float*)d_out; a.ws = (unsigned char*)d_ws;
#if MK_ONE_LAUNCH
    if (hipMemsetAsync((char*)d_ws + WS_BAR, 0, 256, stream) != hipSuccess) { fprintf(stderr, "kernel_launch: memset failed\n"); return; }
    a.ph_lo = 0; a.ph_hi = N_STEPS;
    void* params[] = {&a};
    hipError_t e = hipLaunchCooperativeKernel((const void*)fwd, dim3(grid), dim3(NTHREADS), params, LDS_BYTES, stream);
    if (e != hipSuccess) fprintf(stderr, "cooperative launch failed: %s (grid %d)\n", hipGetErrorString(e), grid);
#else
    for (int k = 0; k < N_STEPS && k < (MK_MAX_STEP > 0 ? MK_MAX_STEP : 1); ++k) { a.ph_lo = k; a.ph_hi = k + 1; hipLaunchKernelGGL(fwd, dim3(grid), dim3(NTHREADS), LDS_BYTES, stream, a); }
#endif
}
```

```cpp
#include <hip/hip_runtime.h>
#include <hip/hip_cooperative_groups.h>
#include <cstdio>
#include <cstdint>
namespace cg = cooperative_groups;
#ifndef MK_MAX_STEP
#define MK_MAX_STEP 100
#define MK_PRO_MASK 7
#endif
#ifndef MK_ONE_LAUNCH
#define MK_ONE_LAUNCH 1
#endif
__device__ __forceinline__ int opaque_tid() { int t = threadIdx.x; asm volatile("" : "+v"(t)); return t; }
__device__ __forceinline__ int opaque_bid() { int b = blockIdx.x; asm volatile("" : "+s"(b)); return b; }
namespace pg8 {
#define PG8_LAS __attribute__((address_space(3)))
typedef unsigned short bf16_t;
typedef short bf16x8 __attribute__((ext_vector_type(8)));
typedef float f32x4 __attribute__((ext_vector_type(4)));
typedef unsigned u32x4 __attribute__((ext_vector_type(4)));
constexpr int BM = 256, BK = 64, HALF = 128, HTB = HALF * BK * 2  , STAGE_BYTES = 8 * HTB, NXCD = 8, WGM = 8;

__host__ __device__ __forceinline__ int lds_byte(int r, int c) { const int st = (r >> 4) * 2 + (c >> 5), rr = r & 15, cc = c & 31, ob = rr * 64 + cc * 2; return st * 1024 + (ob ^ (((ob >> 9) & 1) << 5)); }
__host__ __device__ __forceinline__ void stage_rc(int b, int& R, int& C) { const int st = b / 1024, sb = b % 1024, swz = sb ^ (((sb >> 9) & 1) << 5); R = (st >> 1) * 16 + swz / 64; C = (st & 1) * 32 + (swz % 64) / 2; }
__host__ __device__ __forceinline__ int perm32(int rho) { const int n = rho >> 4, i = rho & 15; return 8 * (i >> 2) + 4 * n + (i & 3); }

struct Unit { int pm, pn; };
struct Gemm { const bf16_t* A; const bf16_t* Bt; int M, N, K; };

struct StaticOrder {
    int nM, nN, nwg, G, c;
    __host__ __device__ void init(int M, int N, int G_, int c_) { nM = M / BM; nN = N / BM; nwg = nM * nN; G = G_; c = c_; }
    __host__ __device__ bool next(int i, Unit& u) const {
        const long L = (long)i * G + c; if (L >= nwg) return false;
        int wgid = (int)L; { const int q = nwg / NXCD, r = nwg % NXCD, xcd = wgid % NXCD, off = wgid / NXCD; wgid = (xcd < r ? xcd * (q + 1) : r * (q + 1) + (xcd - r) * q) + off; }
        const int nig = WGM * nN, gid = wgid / nig, fm = gid * WGM, gsz = (nM - fm) < WGM ? (nM - fm) : WGM;
        u.pm = fm + ((wgid % nig) % gsz); u.pn = (wgid % nig) / gsz; return true;
    }
    __device__ __forceinline__ void a_ready(const Unit&) const {}
    __device__ __forceinline__ void done(const Unit&) const {}
};

typedef unsigned u32x2 __attribute__((ext_vector_type(2)));
typedef float f32x2 __attribute__((ext_vector_type(2)));
typedef __bf16 bf16x2_t __attribute__((ext_vector_type(2)));
__device__ __forceinline__ unsigned cvt_pk_bf16(float lo, float hi) { f32x2 v = {lo, hi}; bf16x2_t b = __builtin_convertvector(v, bf16x2_t); return __builtin_bit_cast(unsigned, b); }
__device__ __forceinline__ float fast_sigmoid(float x) { return __builtin_amdgcn_rcpf(1.0f + __builtin_amdgcn_exp2f(-1.4426950408889634f * x)); }
__device__ __forceinline__ float gelu_tanh(float x) { const float u = 0.7978845608028654f * (x + 0.044715f * x * x * x); return x * fast_sigmoid(2.0f * u); }
__device__ __forceinline__ float silu_f(float x) { return x * fast_sigmoid(x); }

struct EpiProj {
    static constexpr bool PERM = true, AFTER_DRAIN = false;
    bf16_t* O; const float* rowsq; const float* shw;
    __device__ __forceinline__ void operator()(const f32x4 (&acc)[2][2][4][2], const Unit& u, int wr, int wc, int fr, int fq) const {
        const int row0 = u.pm * BM + wr * 64 + fr, col0 = u.pn * BM + wc * 32 + 8 * fq; const bool act = u.pn >= 7;
        f32x4 bv[2][2];
#pragma unroll
        for (int bj = 0; bj < 2; ++bj)
#pragma unroll
            for (int n = 0; n < 2; ++n) bv[bj][n] = rowsq ? *(const f32x4*)(shw + (size_t)(u.pm >> 5) * 2304 + col0 + bj * HALF + 4 * n) : (f32x4){0.f, 0.f, 0.f, 0.f};
        float rsv[2][4];
#pragma unroll
        for (int ai = 0; ai < 2; ++ai)
#pragma unroll
            for (int m = 0; m < 4; ++m) { const int r_ = row0 + ai * HALF + m * 16; rsv[ai][m] = rowsq ? (rowsq[r_] + rowsq[65536 + r_]) + (rowsq[131072 + r_] + rowsq[196608 + r_]) : 0.f; }
#pragma unroll
        for (int ai = 0; ai < 2; ++ai)
#pragma unroll
            for (int m = 0; m < 4; ++m) { bf16_t* rowp = O + (size_t)(row0 + ai * HALF + m * 16) * 2304 + col0;
                const float rs = rowsq ? __builtin_amdgcn_rsqf(rsv[ai][m] * (1.0f / 1024.0f) + 1e-6f) : 1.0f;
#pragma unroll
                for (int bj = 0; bj < 2; ++bj) { f32x4 v0 = acc[ai][bj][m][0] * rs + bv[bj][0], v1 = acc[ai][bj][m][1] * rs + bv[bj][1];
                    if (act) { v0 = (f32x4){gelu_tanh(v0[0]), gelu_tanh(v0[1]), gelu_tanh(v0[2]), gelu_tanh(v0[3])}; v1 = (f32x4){gelu_tanh(v1[0]), gelu_tanh(v1[1]), gelu_tanh(v1[2]), gelu_tanh(v1[3])}; }
                    u32x4 w; w.x = cvt_pk_bf16(v0[0], v0[1]); w.y = cvt_pk_bf16(v0[2], v0[3]); w.z = cvt_pk_bf16(v1[0], v1[1]); w.w = cvt_pk_bf16(v1[2], v1[3]);
                    *(u32x4*)(rowp + bj * HALF) = w; } }
    }
};
struct EpiSwiglu {
    static constexpr bool PERM = true, AFTER_DRAIN = false;
    bf16_t* O; const float* rowsq; const float* shw;
    __device__ __forceinline__ void operator()(const f32x4 (&acc)[2][2][4][2], const Unit& u, int wr, int wc, int fr, int fq) const {
        const int row0 = u.pm * BM + wr * 64 + fr, col0 = u.pn * HALF + wc * 32 + 8 * fq;
        const float* sp = shw + (size_t)(u.pm >> 5) * 5632 + u.pn * BM + wc * 32 + 8 * fq;
        const f32x4 bg0 = *(const f32x4*)(sp), bg1 = *(const f32x4*)(sp + 4), bu0 = *(const f32x4*)(sp + HALF), bu1 = *(const f32x4*)(sp + HALF + 4);
        float rsv[2][4];
#pragma unroll
        for (int ai = 0; ai < 2; ++ai)
#pragma unroll
            for (int m = 0; m < 4; ++m) { const int r_ = row0 + ai * HALF + m * 16; rsv[ai][m] = (rowsq[r_] + rowsq[65536 + r_]) + (rowsq[131072 + r_] + rowsq[196608 + r_]); }
#pragma unroll
        for (int ai = 0; ai < 2; ++ai)
#pragma unroll
            for (int m = 0; m < 4; ++m) { bf16_t* rowp = O + (size_t)(row0 + ai * HALF + m * 16) * 2816 + col0;
                const float rs = __builtin_amdgcn_rsqf(rsv[ai][m] * (1.0f / 1024.0f) + 1e-6f);
                const f32x4 g0 = acc[ai][0][m][0] * rs + bg0, g1 = acc[ai][0][m][1] * rs + bg1, u0 = acc[ai][1][m][0] * rs + bu0, u1 = acc[ai][1][m][1] * rs + bu1;
                u32x4 w; w.x = cvt_pk_bf16(silu_f(g0[0]) * u0[0], silu_f(g0[1]) * u0[1]); w.y = cvt_pk_bf16(silu_f(g0[2]) * u0[2], silu_f(g0[3]) * u0[3]);
                w.z = cvt_pk_bf16(silu_f(g1[0]) * u1[0], silu_f(g1[1]) * u1[1]); w.w = cvt_pk_bf16(silu_f(g1[2]) * u1[2], silu_f(g1[3]) * u1[3]);
                *(u32x4*)rowp = w; }
    }
};
struct EpiRes {
    static constexpr bool PERM = true, AFTER_DRAIN = false;
    bf16_t* x; const float* gate; bf16_t* xs; float* rowsq; const float* gst; PG8_LAS float* sl;
    __device__ __forceinline__ void operator()(f32x4 (&acc)[2][2][4][2], const Unit& u, int wr, int wc, int fr, int fq) const {
        const int col0 = u.pn * BM + wc * 32 + 8 * fq; const float* gp = gate + (size_t)(u.pm >> 5) * 6144 + col0;
        const size_t base = (size_t)(u.pm * BM + wr * 64 + fr) * 1024 + col0;
        u32x4 xb[3][2];
#define EPIRES_LOAD(G) do { _Pragma("unroll") for (int bj_ = 0; bj_ < 2; ++bj_) \
            xb[(G) % 3][bj_] = *(const u32x4*)(x + base + (size_t)(((G) >> 2) * HALF + ((G) & 3) * 16) * 1024 + bj_ * HALF); } while (0)
        EPIRES_LOAD(0); EPIRES_LOAD(1);
        f32x4 gs[2][2];
        { f32x4 gv[2][2];
#pragma unroll
          for (int bj = 0; bj < 2; ++bj)
#pragma unroll
              for (int n = 0; n < 2; ++n) { gv[bj][n] = *(const f32x4*)(gp + bj * HALF + 4 * n);
                  gs[bj][n] = xs ? *(const f32x4*)(gst + (size_t)(u.pm >> 5) * 1024 + col0 + bj * HALF + 4 * n) : (f32x4){0.f, 0.f, 0.f, 0.f}; }
#pragma unroll
          for (int ai = 0; ai < 2; ++ai)
#pragma unroll
              for (int bj = 0; bj < 2; ++bj)
#pragma unroll
                  for (int m = 0; m < 4; ++m)
#pragma unroll
                      for (int n = 0; n < 2; ++n) acc[ai][bj][m][n] *= gv[bj][n]; }
#pragma unroll
        for (int g = 0; g < 8; ++g) { const int ai = g >> 2, m = g & 3;
            if (g + 2 < 8) EPIRES_LOAD(g + 2);
            const int row = u.pm * BM + ai * HALF + wr * 64 + m * 16 + fr; const size_t off = (size_t)row * 1024 + col0; float ssq = 0.f;
#pragma unroll
            for (int bj = 0; bj < 2; ++bj) { const u32x4 xr = xb[g % 3][bj];
                const f32x4 o0 = (f32x4){__uint_as_float(xr.x << 16), __uint_as_float(xr.x & 0xffff0000u), __uint_as_float(xr.y << 16), __uint_as_float(xr.y & 0xffff0000u)} + acc[ai][bj][m][0];
                const f32x4 o1 = (f32x4){__uint_as_float(xr.z << 16), __uint_as_float(xr.z & 0xffff0000u), __uint_as_float(xr.w << 16), __uint_as_float(xr.w & 0xffff0000u)} + acc[ai][bj][m][1];
                u32x4 w; w.x = cvt_pk_bf16(o0[0], o0[1]); w.y = cvt_pk_bf16(o0[2], o0[3]); w.z = cvt_pk_bf16(o1[0], o1[1]); w.w = cvt_pk_bf16(o1[2], o1[3]);
                *(u32x4*)(x + off + bj * HALF) = w;
                if (xs) { ssq += ((o0[0] * o0[0] + o0[1] * o0[1]) + (o0[2] * o0[2] + o0[3] * o0[3])) + ((o1[0] * o1[0] + o1[1] * o1[1]) + (o1[2] * o1[2] + o1[3] * o1[3]));
                    const f32x4 y0 = o0 * gs[bj][0], y1 = o1 * gs[bj][1];
                    u32x4 v; v.x = cvt_pk_bf16(y0[0], y0[1]); v.y = cvt_pk_bf16(y0[2], y0[3]); v.z = cvt_pk_bf16(y1[0], y1[1]); v.w = cvt_pk_bf16(y1[2], y1[3]);
                    *(u32x4*)(xs + off + bj * HALF) = v; } }
            if (xs) { ssq += __shfl_xor(ssq, 16); ssq += __shfl_xor(ssq, 32);
                if (fq == 0) sl[wc * 256 + ai * HALF + wr * 64 + m * 16 + fr] = ssq; } }
#undef EPIRES_LOAD
        if (xs) {
            asm volatile("s_waitcnt lgkmcnt(0)" ::: "memory"); __builtin_amdgcn_s_barrier(); asm volatile("" ::: "memory");
            const int t = (wr * 4 + wc) * 64 + fq * 16 + fr;
            if (t < 256) rowsq[(size_t)u.pn * 65536 + u.pm * BM + t] = (sl[t] + sl[256 + t]) + (sl[512 + t] + sl[768 + t]);
        }
    }
};
template <class Epi, class Sched, bool ALIGN_EPI = false, bool SP2 = false>
__device__ __forceinline__ void gemm_phase(PG8_LAS unsigned char* lds, const Gemm g, const Sched& S, const Epi& E) {
    const int tid = opaque_tid(), wid = __builtin_amdgcn_readfirstlane(tid >> 6), lane = tid & 63, wr = wid >> 2, wc = wid & 3, fr = lane & 15, fq = lane >> 4;
    const int K = g.K, nt = K / BK;
    unsigned voffA[2], voffB[2];
#pragma unroll
    for (int i = 0; i < 2; ++i) { int R, C; stage_rc(tid * 16 + i * 8192, R, C); const int Rb = Epi::PERM ? ((R & ~31) + perm32(R & 31)) : R;
        voffA[i] = (unsigned)(R * K + C) * 2u; voffB[i] = (unsigned)(Rb * K + C) * 2u; }
    const size_t kstep = (size_t)(BK * 2);
    const size_t hstep = (size_t)HALF * K * 2;
    const size_t tstep = 2 * hstep;
    const unsigned ldsw = (unsigned)wid * 1024u;
    const int aoff = lds_byte(wr * 64 + fr, fq * 8), boff = lds_byte(wc * 32 + fr, fq * 8);
#define PG8_SA(b, h) (((b) * 2 + (h)) * HTB)
#define PG8_SB(b, h) ((4 + (b) * 2 + (h)) * HTB)
#define PG8_STAGE(bufoff, gbase, voff) do { _Pragma("unroll") for (int _i = 0; _i < 2; ++_i) \
        __builtin_amdgcn_global_load_lds((const unsigned*)((const char*)(gbase) + (voff)[_i]), (PG8_LAS unsigned*)(lds + (bufoff) + ldsw + _i * 8192), 16, 0, 0); } while (0)
#define PG8_LDA(dst, b, h) do { _Pragma("unroll") for (int m = 0; m < 4; ++m) _Pragma("unroll") for (int k = 0; k < 2; ++k) dst[m][k] = *(const PG8_LAS bf16x8*)(lds + PG8_SA(b, h) + aoff + m * 2048 + k * 1024); } while (0)
#define PG8_LDB(dst, b, h) do { _Pragma("unroll") for (int n = 0; n < 2; ++n) _Pragma("unroll") for (int k = 0; k < 2; ++k) dst[n][k] = *(const PG8_LAS bf16x8*)(lds + PG8_SB(b, h) + boff + n * 2048 + k * 1024); } while (0)
#define PG8_MMA(ai, bj, At, Bt) do { __builtin_amdgcn_s_setprio(1); _Pragma("unroll") for (int m = 0; m < 4; ++m) _Pragma("unroll") for (int n = 0; n < 2; ++n) _Pragma("unroll") for (int k = 0; k < 2; ++k) \
        acc[ai][bj][m][n] = __builtin_amdgcn_mfma_f32_16x16x32_bf16(Bt[n][k], At[m][k], acc[ai][bj][m][n], 0, 0, 0); __builtin_amdgcn_s_setprio(0); } while (0)
#define PG8_WAIT_V(n) asm volatile("s_waitcnt vmcnt(" #n ")" ::: "memory")
#define PG8_WAIT_L(n) asm volatile("s_waitcnt lgkmcnt(" #n ")" ::: "memory")
#define PG8_BAR __builtin_amdgcn_s_barrier()
#define PG8_SCHED __builtin_amdgcn_sched_barrier(0)
    Unit cur, nxt; int ui = 0;
    if (!S.next(0, cur)) return;
    f32x4 acc[2][2][4][2];
#pragma unroll
    for (int a = 0; a < 2; ++a)
#pragma unroll
        for (int b = 0; b < 2; ++b)
#pragma unroll
            for (int m = 0; m < 4; ++m)
#pragma unroll
                for (int n = 0; n < 2; ++n) acc[a][b][m][n] = (f32x4){0.f, 0.f, 0.f, 0.f};
    bf16x8 At[4][2], B0[2][2], B1[2][2];
    const char* cA = (const char*)g.A + (size_t)cur.pm * tstep; const char* cB = (const char*)g.Bt + (size_t)cur.pn * tstep;
    S.a_ready(cur);
    if constexpr (SP2) {
        PG8_STAGE(PG8_SB(0, 0), cB, voffB); PG8_STAGE(PG8_SB(0, 1), cB + hstep, voffB); PG8_STAGE(PG8_SA(0, 0), cA, voffA); PG8_STAGE(PG8_SA(0, 1), cA + hstep, voffA);
        if (wr == 1) PG8_BAR;
        PG8_WAIT_V(2); PG8_BAR;
        PG8_STAGE(PG8_SB(1, 0), cB + kstep, voffB); PG8_STAGE(PG8_SA(1, 0), cA + kstep, voffA); PG8_STAGE(PG8_SB(1, 1), cB + hstep + kstep, voffB);
        PG8_WAIT_V(6); PG8_BAR;
    } else {
        PG8_STAGE(PG8_SB(0, 0), cB, voffB); PG8_STAGE(PG8_SA(0, 0), cA, voffA); PG8_STAGE(PG8_SB(0, 1), cB + hstep, voffB); PG8_STAGE(PG8_SA(0, 1), cA + hstep, voffA);
        if (wr == 1) PG8_BAR;
        PG8_WAIT_V(4); PG8_BAR;
        PG8_STAGE(PG8_SB(1, 0), cB + kstep, voffB); PG8_STAGE(PG8_SA(1, 0), cA + kstep, voffA); PG8_STAGE(PG8_SB(1, 1), cB + hstep + kstep, voffB);
        PG8_WAIT_V(6); PG8_BAR;
    }
    for (;;) {
        const bool has_next = S.next(ui + 1, nxt);
        const char* nA = has_next ? (const char*)g.A + (size_t)nxt.pm * tstep : cA; const char* nB = has_next ? (const char*)g.Bt + (size_t)nxt.pn * tstep : cB;
        for (int t = 0; t < nt; t += 2) {
            const bool last = (t == nt - 2);
            const char* a1 = cA + (size_t)(t + 1) * kstep;
            const char* a2 = last ? nA : cA + (size_t)(t + 2) * kstep; const char* b2 = last ? nB : cB + (size_t)(t + 2) * kstep;
            const char* a3 = a2 + kstep; const char* b3 = b2 + kstep;
            if (last && has_next) S.a_ready(nxt);
            if constexpr (SP2) {
            PG8_LDB(B0, 0, 0); PG8_LDB(B1, 0, 1); PG8_SCHED; PG8_LDA(At, 0, 0); PG8_STAGE(PG8_SA(1, 1), a1 + hstep, voffA);
            PG8_WAIT_V(8); PG8_WAIT_L(0); PG8_BAR; PG8_MMA(0, 0, At, B0); PG8_MMA(0, 1, At, B1); PG8_BAR; PG8_SCHED;
            PG8_LDA(At, 0, 1); PG8_STAGE(PG8_SB(0, 0), b2, voffB); PG8_STAGE(PG8_SB(0, 1), b2 + hstep, voffB); PG8_STAGE(PG8_SA(0, 0), a2, voffA);
            PG8_WAIT_V(8); PG8_WAIT_L(0); PG8_BAR; PG8_MMA(1, 0, At, B0); PG8_MMA(1, 1, At, B1); PG8_BAR; PG8_SCHED;
            PG8_LDB(B0, 1, 0); PG8_LDB(B1, 1, 1); PG8_SCHED; PG8_LDA(At, 1, 0); PG8_STAGE(PG8_SA(0, 1), a2 + hstep, voffA);
            PG8_WAIT_V(8); PG8_WAIT_L(0); PG8_BAR; PG8_MMA(0, 0, At, B0); PG8_MMA(0, 1, At, B1); PG8_BAR; PG8_SCHED;
            PG8_LDA(At, 1, 1); PG8_STAGE(PG8_SB(1, 0), b3, voffB); PG8_STAGE(PG8_SB(1, 1), b3 + hstep, voffB); PG8_STAGE(PG8_SA(1, 0), a3, voffA);
            PG8_WAIT_V(8); PG8_WAIT_L(0); PG8_BAR; PG8_MMA(1, 0, At, B0); PG8_MMA(1, 1, At, B1); PG8_BAR; PG8_SCHED;
            } else {
            PG8_LDB(B0, 0, 0); PG8_SCHED; PG8_LDA(At, 0, 0); PG8_STAGE(PG8_SA(1, 1), a1 + hstep, voffA);
            PG8_WAIT_L(8); PG8_BAR; PG8_WAIT_L(0); PG8_MMA(0, 0, At, B0); PG8_BAR; PG8_SCHED;
            PG8_LDB(B1, 0, 1); PG8_STAGE(PG8_SB(0, 0), b2, voffB);
            PG8_BAR; PG8_WAIT_L(0); PG8_MMA(0, 1, At, B1); PG8_BAR;
            PG8_LDA(At, 0, 1); PG8_STAGE(PG8_SA(0, 0), a2, voffA);
            PG8_BAR; PG8_WAIT_L(0); PG8_MMA(1, 0, At, B0); PG8_BAR; PG8_SCHED;
            PG8_STAGE(PG8_SB(0, 1), b2 + hstep, voffB);
            PG8_WAIT_V(6); PG8_BAR; PG8_MMA(1, 1, At, B1); PG8_BAR;
            PG8_LDB(B0, 1, 0); PG8_SCHED; PG8_LDA(At, 1, 0); PG8_STAGE(PG8_SA(0, 1), a2 + hstep, voffA);
            PG8_WAIT_L(8); PG8_BAR; PG8_WAIT_L(0); PG8_MMA(0, 0, At, B0); PG8_BAR; PG8_SCHED;
            PG8_LDB(B1, 1, 1); PG8_STAGE(PG8_SB(1, 0), b3, voffB);
            PG8_BAR; PG8_WAIT_L(0); PG8_MMA(0, 1, At, B1); PG8_BAR;
            PG8_LDA(At, 1, 1); PG8_STAGE(PG8_SA(1, 0), a3, voffA);
            PG8_BAR; PG8_WAIT_L(0); PG8_MMA(1, 0, At, B0); PG8_BAR; PG8_SCHED;
            PG8_STAGE(PG8_SB(1, 1), b3 + hstep, voffB);
            PG8_WAIT_V(6); PG8_BAR; PG8_MMA(1, 1, At, B1); PG8_BAR;
            }
        }
        if constexpr (ALIGN_EPI) { if (wr == 0) PG8_BAR; }
        if constexpr (!Epi::AFTER_DRAIN) { E(acc, cur, wr, wc, fr, fq); S.done(cur); }
        if (!has_next) break;
#pragma unroll
        for (int a = 0; a < 2; ++a)
#pragma unroll
            for (int b = 0; b < 2; ++b)
#pragma unroll
                for (int m = 0; m < 4; ++m)
#pragma unroll
                    for (int n = 0; n < 2; ++n) acc[a][b][m][n] = (f32x4){0.f, 0.f, 0.f, 0.f};
        cur = nxt; cA = nA; cB = nB; ++ui;
        if constexpr (ALIGN_EPI) { if (wr == 1) PG8_BAR; }
    }
    PG8_WAIT_V(0);
    if constexpr (!ALIGN_EPI) { if (wr == 0) PG8_BAR; }
    PG8_BAR;
    if constexpr (Epi::AFTER_DRAIN) { E.fused(acc, cur, wr, wc, fr, fq, lds, wid, lane); S.done(cur); }
#undef PG8_SA
#undef PG8_SB
#undef PG8_STAGE
#undef PG8_LDA
#undef PG8_LDB
#undef PG8_MMA
#undef PG8_WAIT_V
#undef PG8_WAIT_L
#undef PG8_BAR
#undef PG8_SCHED
}
}
#define LAS __attribute__((address_space(3)))
typedef unsigned short bf16_t;
typedef short bf16x8 __attribute__((ext_vector_type(8)));
typedef short s16x4 __attribute__((ext_vector_type(4)));
typedef float f32x4 __attribute__((ext_vector_type(4)));
typedef float f32x16 __attribute__((ext_vector_type(16)));
typedef unsigned u32x4 __attribute__((ext_vector_type(4)));
typedef unsigned u32x2 __attribute__((ext_vector_type(2)));
using pg8::cvt_pk_bf16;
constexpr int NB = 8, SEQ = 8192, D = 1024, M = NB * SEQ, INW = 2304, FF = 2816, GU = 2 * FF, DEPTH = 4, NMOD = 6144;
constexpr float EPS = 1e-6f;
constexpr size_t MiB = 1u << 20;
constexpr size_t WS_MOD = 0;
constexpr size_t WS_WSB = 1 * MiB;
constexpr size_t WS_WPB = WS_WSB + 512 * 1024;
constexpr size_t WS_W = 2 * MiB;
constexpr size_t W_IN_OFF = 0, W_OUT_OFF = 5 * MiB, W_GU_OFF = 7 * MiB, W_DN_OFF = 18 * MiB, W_LAYER = 23 * MiB + 512 * 1024;
constexpr size_t WS_H = 96 * MiB;
constexpr size_t WS_P = 224 * MiB;
constexpr size_t WS_END = 576 * MiB;
constexpr size_t WS_SHW1 = 577 * MiB;
constexpr size_t WS_SHW2 = 578 * MiB;
constexpr size_t WS_RSQA = 836 * MiB, WS_RSQB = 837 * MiB;
constexpr size_t WS_XS2 = 580 * MiB;
constexpr size_t WS_XB = 708 * MiB;
constexpr size_t WS_END2 = 838 * MiB;
constexpr size_t WS_GST = 576 * MiB + 512 * 1024;
constexpr size_t WS_BAR = WS_END;
static_assert(WS_W + 4 * W_LAYER <= WS_H && WS_H + (size_t)M * D * 2 <= WS_P && WS_P + (size_t)M * FF * 2 <= WS_END, "ws map");
constexpr int LDS_BYTES = 147456;
constexpr int NTHREADS = 512;

__device__ __forceinline__ void grid_bar(unsigned* ctr, unsigned& target) {
    target += gridDim.x;
    asm volatile("s_waitcnt vmcnt(0)" ::: "memory");
    __syncthreads();
    if (threadIdx.x == 0) {
        __builtin_amdgcn_fence(__ATOMIC_RELEASE, "agent");
        asm volatile("s_waitcnt vmcnt(0)" ::: "memory");
        __hip_atomic_fetch_add(ctr, 1u, __ATOMIC_RELAXED, __HIP_MEMORY_SCOPE_AGENT);
        while (__hip_atomic_load(ctr, __ATOMIC_RELAXED, __HIP_MEMORY_SCOPE_AGENT) < target) __builtin_amdgcn_s_sleep(1);
        __builtin_amdgcn_fence(__ATOMIC_ACQUIRE, "agent");
        asm volatile("s_waitcnt vmcnt(0)" ::: "memory");
    }
    __syncthreads();
}
struct Args { const float* in[17]; float* out; unsigned char* ws; int ph_lo, ph_hi; };

__device__ __forceinline__ float wave_sum(float v) {
#pragma unroll
    for (int o = 1; o < 64; o <<= 1) v += __shfl_xor(v, o);
    return v;
}
__device__ __forceinline__ float bf2f(unsigned short b) { return __uint_as_float((unsigned)b << 16); }
__device__ __forceinline__ float bflo(unsigned w) { return __uint_as_float(w << 16); }
__device__ __forceinline__ float bfhi(unsigned w) { return __uint_as_float(w & 0xffff0000u); }
__device__ __forceinline__ int crow(int reg, int h) { return (reg & 3) + 8 * (reg >> 2) + 4 * h; }
#define MFMA32(a, b, c) __builtin_amdgcn_mfma_f32_32x32x16_bf16((a), (b), (c), 0, 0, 0)
typedef short v4i16_t __attribute__((ext_vector_type(4)));
__device__ __forceinline__ s16x4 vtr(LAS const unsigned char* p) { return __builtin_bit_cast(s16x4, __builtin_amdgcn_ds_read_tr16_b64_v4i16((LAS v4i16_t*)p)); }
__device__ __forceinline__ bf16x8 cat8(s16x4 lo, s16x4 hi) { return __builtin_shufflevector(lo, hi, 0, 1, 2, 3, 4, 5, 6, 7); }

__device__ __forceinline__ void phase_pro(const Args& a, LAS unsigned char* lds) {
    const int tid = opaque_tid(), G = gridDim.x, bid = opaque_bid();
    LAS float* sc = (LAS float*)lds; LAS float* red = (LAS float*)(lds + 32768);
    { const float* c = a.in[1];
      for (int i = tid; i < NB * D; i += NTHREADS) { const float v = c[i]; sc[i] = v * pg8::fast_sigmoid(v); } }
    __syncthreads();
    float* mod = (float*)(a.ws + WS_MOD);
    if (MK_PRO_MASK & 1)
    for (int item = bid; item < DEPTH * 192; item += G) {
        const int l = item / 192, cgp = item % 192, kp = tid >> 3, n4 = tid & 7;
        float acc[8][4];
#pragma unroll
        for (int b = 0; b < 8; ++b)
#pragma unroll
            for (int j = 0; j < 4; ++j) acc[b][j] = 0.f;
        const float* wp = a.in[2] + ((size_t)l * D + kp * 16) * NMOD + cgp * 32 + n4 * 4;
#pragma unroll 4
        for (int k = 0; k < 16; ++k) {
            const f32x4 w = *(const f32x4*)(wp + (size_t)k * NMOD);
#pragma unroll
            for (int b = 0; b < 8; ++b) { const float s = sc[b * D + kp * 16 + k]; acc[b][0] += s * w[0]; acc[b][1] += s * w[1]; acc[b][2] += s * w[2]; acc[b][3] += s * w[3]; }
        }
#pragma unroll
        for (int b = 0; b < 8; ++b)
#pragma unroll
            for (int j = 0; j < 4; ++j) red[(kp * 8 + b) * 32 + n4 * 4 + j] = acc[b][j];
        __syncthreads();
        if (tid < 256) { const int b = tid >> 5, col = tid & 31; float s = 0.f;
            for (int k2 = 0; k2 < 64; ++k2) s += red[(k2 * 8 + b) * 32 + col];
            mod[(size_t)(l * 8 + b) * NMOD + cgp * 32 + col] = s + a.in[3][l * NMOD + cgp * 32 + col]; }
        __syncthreads();
    }
    LAS float* tile = (LAS float*)lds;
    if (MK_PRO_MASK & 2)
    for (int it = bid; it < DEPTH * 2944; it += G) {
        const int l = it / 2944; int r = it % 2944;
        const float* W; int K, N, kt, nt, kind = 0; size_t woff;
        if (r < 576) { W = a.in[5] + (size_t)l * D * INW; K = D; N = INW; kt = r / 36; nt = r % 36; woff = W_IN_OFF; }
        else if (r < 832) { r -= 576; W = a.in[12] + (size_t)l * D * D; K = D; N = D; kt = r / 16; nt = r % 16; woff = W_OUT_OFF; }
        else if (r < 2240) { r -= 832; W = a.in[14] + (size_t)l * D * GU; K = D; N = GU; kt = r / 88; nt = r % 88; woff = W_GU_OFF; kind = 1; }
        else { r -= 2240; W = a.in[15] + (size_t)l * FF * D; K = FF; N = D; kt = r / 16; nt = r % 16; woff = W_DN_OFF; }
        bf16_t* WT = (bf16_t*)(a.ws + WS_W + (size_t)l * W_LAYER + woff);
        const int n0 = nt * 64, k0 = kt * 64;
        int dn0 = n0;
        if (kind == 1) { dn0 = n0 < FF ? (n0 / 128) * 256 + (n0 % 128) : ((n0 - FF) / 128) * 256 + 128 + ((n0 - FF) % 128); }
#pragma unroll
        for (int p = 0; p < 2; ++p) { const int row = (tid >> 4) + 32 * p, c4 = tid & 15;
            const f32x4 v = *(const f32x4*)(W + (size_t)(k0 + row) * N + n0 + 4 * c4);
            tile[row * 65 + 4 * c4 + 0] = v[0]; tile[row * 65 + 4 * c4 + 1] = v[1]; tile[row * 65 + 4 * c4 + 2] = v[2]; tile[row * 65 + 4 * c4 + 3] = v[3]; }
        __syncthreads();
        { const int n = tid >> 3, kc = tid & 7; LAS const float* s = tile + (8 * kc) * 65 + n;
          u32x4 o; o.x = cvt_pk_bf16(s[0], s[65]); o.y = cvt_pk_bf16(s[2 * 65], s[3 * 65]); o.z = cvt_pk_bf16(s[4 * 65], s[5 * 65]); o.w = cvt_pk_bf16(s[6 * 65], s[7 * 65]);
          *(u32x4*)(WT + (size_t)(dn0 + n) * K + k0 + 8 * kc) = o; }
        __syncthreads();
    }
    if (MK_PRO_MASK & 4)
    { const float* ws_ = a.in[9]; bf16_t* wsb = (bf16_t*)(a.ws + WS_WSB);
      for (int i = bid * NTHREADS + tid; i < DEPTH * 4 * 128 * 128; i += G * NTHREADS) { const int s = i & 127, t = (i >> 7) & 127; const float v = (s <= t) ? ws_[i] : 0.f; wsb[i] = (bf16_t)(cvt_pk_bf16(v, 0.f) & 0xffffu); }
      const float* wp_ = a.in[6]; bf16_t* wpb = (bf16_t*)(a.ws + WS_WPB);
      for (int i = bid * NTHREADS + tid; i < DEPTH * 4 * 64 * 64; i += G * NTHREADS) { const int c = i & 63, e = (i >> 6) & 63, lg = i >> 12; wpb[i] = (bf16_t)(cvt_pk_bf16(wp_[(lg * 64 + c) * 64 + e], 0.f) & 0xffffu); } }
}

__device__ __forceinline__ void phase_pro2(const Args& a) {
    const int tid = opaque_tid(), lane = tid & 63, wave = tid >> 6, gw = opaque_bid() * 8 + wave, NGW = gridDim.x * 8;
    const int pair = gw & 7, l = pair >> 1, which = pair & 1, N = which ? GU : INW;
    const float* sh = (const float*)(a.ws + WS_MOD) + (size_t)l * 8 * NMOD + (which ? 3072 : 0);
    const bf16_t* WT = (const bf16_t*)(a.ws + WS_W + (size_t)l * W_LAYER + (which ? W_GU_OFF : W_IN_OFF));
    float* out = (float*)(a.ws + (which ? WS_SHW2 : WS_SHW1)) + (size_t)l * 8 * N;
    f32x4 sv[8][4];
#pragma unroll
    for (int b = 0; b < 8; ++b)
#pragma unroll
        for (int j = 0; j < 4; ++j) sv[b][j] = *(const f32x4*)(sh + (size_t)b * NMOD + 16 * lane + 4 * j);
    for (int n = gw >> 3; n < N; n += NGW >> 3) {
        const u32x4 w0 = *(const u32x4*)(WT + (size_t)n * D + 16 * lane), w1 = *(const u32x4*)(WT + (size_t)n * D + 16 * lane + 8);
        const f32x4 f0 = {bflo(w0.x), bfhi(w0.x), bflo(w0.y), bfhi(w0.y)}, f1 = {bflo(w0.z), bfhi(w0.z), bflo(w0.w), bfhi(w0.w)};
        const f32x4 f2 = {bflo(w1.x), bfhi(w1.x), bflo(w1.y), bfhi(w1.y)}, f3 = {bflo(w1.z), bfhi(w1.z), bflo(w1.w), bfhi(w1.w)};
        float r[8];
#pragma unroll
        for (int b = 0; b < 8; ++b) { const f32x4 p = sv[b][0] * f0 + sv[b][1] * f1 + sv[b][2] * f2 + sv[b][3] * f3; r[b] = wave_sum((p[0] + p[1]) + (p[2] + p[3])); }
        if (lane == 0) {
#pragma unroll
            for (int b = 0; b < 8; ++b) out[(size_t)b * N + n] = r[b]; }
    }
}
__device__ __forceinline__ void phase_gst(const Args& a) {
    const float* mod = (const float*)(a.ws + WS_MOD); float* gst = (float*)(a.ws + WS_GST);
    for (int i = opaque_bid() * NTHREADS + opaque_tid(); i < DEPTH * 2 * 8 * D; i += gridDim.x * NTHREADS) {
        const int k = i & 1023, b = (i >> 10) & 7, which = (i >> 13) & 1, l = i >> 14;
        gst[i] = a.in[which ? 13 : 4][l * D + k] * (1.0f + mod[(size_t)(l * 8 + b) * NMOD + (which ? 4096 : 1024) + k]); }
}
__device__ __forceinline__ void zero_rows(float* p) {
    for (int i = opaque_bid() * NTHREADS + opaque_tid(); i < M; i += gridDim.x * NTHREADS) p[i] = 0.f;
}

__device__ __forceinline__ void phase_norm(const float* xin, const float* g, const float* sh, const float* sc, bf16_t* hout, bf16_t* xbout) {
    const int tid = opaque_tid(), lane = tid & 63, wave = tid >> 6, gw = opaque_bid() * 8 + wave, NGW = gridDim.x * 8;
    const int b = gw & 7, r0 = gw >> 3, rstep = NGW >> 3;
    f32x4 gs[4], sv[4];
#pragma unroll
    for (int j = 0; j < 4; ++j) { const int col = 4 * lane + 256 * j; const f32x4 gg = *(const f32x4*)(g + col), ss = *(const f32x4*)(sc + (size_t)b * NMOD + col);
        gs[j] = gg * (ss + 1.0f); sv[j] = *(const f32x4*)(sh + (size_t)b * NMOD + col); }
    for (int r = r0; r < SEQ; r += rstep) {
        const size_t row = (size_t)b * SEQ + r; const f32x4* xr = (const f32x4*)(xin + row * D) + lane;
        f32x4 v[4]; float s = 0.f;
#pragma unroll
        for (int j = 0; j < 4; ++j) { v[j] = xr[64 * j]; s += (v[j][0] * v[j][0] + v[j][1] * v[j][1]) + (v[j][2] * v[j][2] + v[j][3] * v[j][3]); }
        const float rstd = __builtin_amdgcn_rsqf(wave_sum(s) * (1.0f / D) + EPS);
        u32x2* o = (u32x2*)(hout + row * D) + lane; u32x2* ox = (u32x2*)(xbout + row * D) + lane;
#pragma unroll
        for (int j = 0; j < 4; ++j) { const f32x4 y = v[j] * rstd * gs[j] + sv[j]; u32x2 w; w.x = cvt_pk_bf16(y[0], y[1]); w.y = cvt_pk_bf16(y[2], y[3]); o[64 * j] = w;
            u32x2 wx; wx.x = cvt_pk_bf16(v[j][0], v[j][1]); wx.y = cvt_pk_bf16(v[j][2], v[j][3]); ox[64 * j] = wx; }
    }
}
__device__ __forceinline__ void phase_final(const bf16_t* xb, const float* g, float* out) {
    const int tid = opaque_tid(), lane = tid & 63, wave = tid >> 6, gw = opaque_bid() * 8 + wave, NGW = gridDim.x * 8;
    f32x4 gs[4];
#pragma unroll
    for (int j = 0; j < 4; ++j) gs[j] = *(const f32x4*)(g + 4 * lane + 256 * j);
    for (int row = gw; row < M; row += NGW) {
        const u32x2* xr = (const u32x2*)(xb + (size_t)row * D) + lane; f32x4 v[4]; float s = 0.f;
#pragma unroll
        for (int j = 0; j < 4; ++j) { const u32x2 r = xr[64 * j]; v[j] = (f32x4){bflo(r.x), bfhi(r.x), bflo(r.y), bfhi(r.y)}; s += (v[j][0] * v[j][0] + v[j][1] * v[j][1]) + (v[j][2] * v[j][2] + v[j][3] * v[j][3]); }
        const float rstd = __builtin_amdgcn_rsqf(wave_sum(s) * (1.0f / D) + EPS);
        f32x4* o = (f32x4*)(out + (size_t)row * D) + lane;
#pragma unroll
        for (int j = 0; j < 4; ++j) o[64 * j] = v[j] * rstd * gs[j];
    }
}
__device__ __forceinline__ void attn_unit(int unit, const bf16_t* proj, bf16_t* merged, const float* mn, LAS unsigned char* lds, int wave, int lane) {
    const int b = unit >> 8, q0 = (unit & 255) * 32, n = lane & 31, h = lane >> 5, hd = wave;
    const size_t rowbase = (size_t)b * SEQ;
    constexpr float C1 = 0.125f * 1.4426950408889634f;
    bf16x8 bq[4];
    { const bf16_t* qp = proj + (rowbase + q0 + n) * INW + hd * 64 + 8 * h;
#pragma unroll
      for (int s = 0; s < 4; ++s) bq[s] = *(const bf16x8*)(qp + 16 * s); }
    f32x16 o0, o1;
#pragma unroll
    for (int i = 0; i < 16; ++i) { o0[i] = 0.f; o1[i] = 0.f; }
    float carry = 1.f;
    LAS unsigned char* kl = lds + wave * 9216; LAS unsigned char* vl = kl + 4608;
    const int nkt = min(17, (q0 >> 5) + 1);
    const int q4 = (lane & 15) >> 2, p4 = lane & 3, blk = (lane >> 4) & 1;
    u32x4 kv[4], vv[4];
    const bf16_t* kp = proj + (rowbase + q0) * INW + 512 + hd * 64 + (size_t)(lane >> 3) * INW + (lane & 7) * 8;
#pragma unroll
    for (int i = 0; i < 4; ++i) { kv[i] = *(const u32x4*)(kp + (size_t)(8 * i) * INW); vv[i] = *(const u32x4*)(kp + 512 + (size_t)(8 * i) * INW); }
    for (int kt = 0; kt < nkt; ++kt) {
#pragma unroll
        for (int i = 0; i < 4; ++i) { const int c = lane + 64 * i, row = c >> 3, ch = c & 7; *(LAS u32x4*)(kl + row * 144 + ch * 16) = kv[i]; *(LAS u32x4*)(vl + row * 144 + ch * 16) = vv[i]; }
        if (kt + 1 < nkt) { kp -= (size_t)32 * INW;
#pragma unroll
            for (int i = 0; i < 4; ++i) { kv[i] = *(const u32x4*)(kp + (size_t)(8 * i) * INW); vv[i] = *(const u32x4*)(kp + 512 + (size_t)(8 * i) * INW); } }
        asm volatile("s_waitcnt lgkmcnt(0)" ::: "memory");
        f32x16 st;
#pragma unroll
        for (int i = 0; i < 16; ++i) st[i] = 0.f;
#pragma unroll
        for (int s = 0; s < 4; ++s) { const bf16x8 ka = *(LAS const bf16x8*)(kl + n * 144 + (2 * s + h) * 16); st = MFMA32(ka, bq[s], st); }
        float be[16], om[16], w[16];
#pragma unroll
        for (int i = 0; i < 16; ++i) {
            const float e = __builtin_amdgcn_exp2f(fminf(st[i] * (-C1), 80.f));
            be[i] = __builtin_amdgcn_rcpf(1.0f + e);
            om[i] = e * be[i];
        }
        if (kt == 0 || kt == 16) {
#pragma unroll
            for (int i = 0; i < 16; ++i) { const bool valid = (kt == 0) ? (crow(i, h) < n) : (crow(i, h) >= n); be[i] = valid ? be[i] : 0.f; om[i] = valid ? om[i] : 1.f; }
        }
        const float G0 = (om[0] * om[1]) * (om[2] * om[3]), G1 = (om[4] * om[5]) * (om[6] * om[7]), G2 = (om[8] * om[9]) * (om[10] * om[11]), G3 = (om[12] * om[13]) * (om[14] * om[15]);
        const float P0 = __shfl_xor(G0, 32), P1 = __shfl_xor(G1, 32), P2 = __shfl_xor(G2, 32), P3 = __shfl_xor(G3, 32);
        const float S2 = G3 * P3, S1 = S2 * (G2 * P2), S0 = S1 * (G1 * P1), tot = S0 * (G0 * P0);
        float T[4]; T[0] = S0 * (h == 0 ? P0 : 1.f); T[1] = S1 * (h == 0 ? P1 : 1.f); T[2] = S2 * (h == 0 ? P2 : 1.f); T[3] = (h == 0 ? P3 : 1.f);
#pragma unroll
        for (int g = 0; g < 4; ++g) {
            float later = carry * T[g];
#pragma unroll
            for (int j = 3; j >= 0; --j) { const int i = 4 * g + j; w[i] = be[i] * later; later *= om[i]; }
        }
        carry *= tot;
        const bool done = __builtin_amdgcn_ballot_w64(carry >= 1e-20f) == 0ull;
        bf16x8 wf[2];
#pragma unroll
        for (int s = 0; s < 2; ++s) { u32x4 p; p.x = cvt_pk_bf16(w[8 * s], w[8 * s + 1]); p.y = cvt_pk_bf16(w[8 * s + 2], w[8 * s + 3]); p.z = cvt_pk_bf16(w[8 * s + 4], w[8 * s + 5]); p.w = cvt_pk_bf16(w[8 * s + 6], w[8 * s + 7]); wf[s] = __builtin_bit_cast(bf16x8, p); }
#pragma unroll
        for (int s = 0; s < 2; ++s) {
            LAS const unsigned char* vb = vl + (16 * s + 4 * h + q4) * 144 + 32 * blk + 8 * p4;
            const s16x4 lo0 = vtr(vb), hi0 = vtr(vb + 8 * 144), lo1 = vtr(vb + 64), hi1 = vtr(vb + 8 * 144 + 64);
            o0 = MFMA32(cat8(lo0, hi0), wf[s], o0);
            o1 = MFMA32(cat8(lo1, hi1), wf[s], o1);
        }
        asm volatile("" ::: "memory");
        if (done) break;
    }
    float ss = 0.f;
#pragma unroll
    for (int i = 0; i < 16; ++i) ss += o0[i] * o0[i] + o1[i] * o1[i];
    ss += __shfl_xor(ss, 32);
    LAS float* ex = (LAS float*)(lds + 73728 + (unit & 1) * 1024);
    if (h == 0) ex[wave * 32 + n] = ss;
    const float* mp = mn + hd * 64 + 4 * h;
    f32x4 mv0[4], mv1[4];
#pragma unroll
    for (int g = 0; g < 4; ++g) { mv0[g] = *(const f32x4*)(mp + 8 * g); mv1[g] = *(const f32x4*)(mp + 32 + 8 * g); }
    __syncthreads();
    float tot = 0.f;
#pragma unroll
    for (int w8 = 0; w8 < 8; ++w8) tot += ex[w8 * 32 + n];
    const float rstd = __builtin_amdgcn_rsqf(tot * (1.0f / 512.0f) + EPS);
    bf16_t* op = merged + (rowbase + q0 + n) * D + hd * 64 + 4 * h;
#pragma unroll
    for (int g = 0; g < 4; ++g) {
        const f32x4 m0 = mv0[g], m1 = mv1[g];
        u32x2 a0, a1;
        a0.x = cvt_pk_bf16(o0[4 * g] * rstd * m0[0], o0[4 * g + 1] * rstd * m0[1]); a0.y = cvt_pk_bf16(o0[4 * g + 2] * rstd * m0[2], o0[4 * g + 3] * rstd * m0[3]);
        a1.x = cvt_pk_bf16(o1[4 * g] * rstd * m1[0], o1[4 * g + 1] * rstd * m1[1]); a1.y = cvt_pk_bf16(o1[4 * g + 2] * rstd * m1[2], o1[4 * g + 3] * rstd * m1[3]);
        *(u32x2*)(op + 8 * g) = a0; *(u32x2*)(op + 32 + 8 * g) = a1;
    }
}

__device__ __forceinline__ void sg_unit(int unit, const bf16_t* proj, bf16_t* merged, const float* mn, const float* sgn, const bf16_t* wsb, const float* bs, LAS unsigned char* lds, int tid, int wave, int lane) {
    const size_t R0 = (size_t)unit * 128;
    constexpr int RS = 528;
    { const int t = tid >> 2, part = tid & 3;
      const bf16_t* vp = proj + (R0 + t) * INW + 2048 + 64 * part;
      u32x4 raw[8];
#pragma unroll
      for (int i = 0; i < 8; ++i) raw[i] = *(const u32x4*)(vp + 8 * i);
      float s = 0.f;
#pragma unroll
      for (int i = 0; i < 8; ++i) s += (bflo(raw[i].x) + bfhi(raw[i].x)) + (bflo(raw[i].y) + bfhi(raw[i].y)) + (bflo(raw[i].z) + bfhi(raw[i].z)) + (bflo(raw[i].w) + bfhi(raw[i].w));
      s += __shfl_xor(s, 1); s += __shfl_xor(s, 2);
      const float mean = s * (1.0f / 256.0f);
      float q = 0.f;
#pragma unroll
      for (int i = 0; i < 8; ++i) { float d;
          d = bflo(raw[i].x) - mean; q += d * d; d = bfhi(raw[i].x) - mean; q += d * d; d = bflo(raw[i].y) - mean; q += d * d; d = bfhi(raw[i].y) - mean; q += d * d;
          d = bflo(raw[i].z) - mean; q += d * d; d = bfhi(raw[i].z) - mean; q += d * d; d = bflo(raw[i].w) - mean; q += d * d; d = bfhi(raw[i].w) - mean; q += d * d; }
      q += __shfl_xor(q, 1); q += __shfl_xor(q, 2);
      const float rstd = __builtin_amdgcn_rsqf(q * (1.0f / 256.0f) + EPS);
      const float* gp = sgn + 64 * part;
#pragma unroll
      for (int i = 0; i < 8; ++i) { const f32x4 ga = *(const f32x4*)(gp + 8 * i), gb = *(const f32x4*)(gp + 8 * i + 4); u32x4 o;
          o.x = cvt_pk_bf16((bflo(raw[i].x) - mean) * rstd * ga[0], (bfhi(raw[i].x) - mean) * rstd * ga[1]); o.y = cvt_pk_bf16((bflo(raw[i].y) - mean) * rstd * ga[2], (bfhi(raw[i].y) - mean) * rstd * ga[3]);
          o.z = cvt_pk_bf16((bflo(raw[i].z) - mean) * rstd * gb[0], (bfhi(raw[i].z) - mean) * rstd * gb[1]); o.w = cvt_pk_bf16((bflo(raw[i].w) - mean) * rstd * gb[2], (bfhi(raw[i].w) - mean) * rstd * gb[3]);
          *(LAS u32x4*)(lds + t * RS + 2 * (64 * part + 8 * i)) = o; }
    }
    __syncthreads();
    const int h4 = wave >> 1, dh = wave & 1, n = lane & 31, h = lane >> 5, cbase = 64 * h4 + 32 * dh;
    const int q4 = (lane & 15) >> 2, p4 = lane & 3, blk = (lane >> 4) & 1;
    f32x16 acc[4];
#pragma unroll
    for (int tt = 0; tt < 4; ++tt)
#pragma unroll
        for (int i = 0; i < 16; ++i) acc[tt][i] = 0.f;
#pragma unroll
    for (int ks = 0; ks < 8; ++ks) {
        LAS const unsigned char* vb = lds + (16 * ks + 8 * h + q4) * RS + 2 * (cbase + 16 * blk) + 8 * p4;
        const bf16x8 af = cat8(vtr(vb), vtr(vb + 4 * RS));
#pragma unroll
        for (int tt = 0; tt < 4; ++tt) if (ks < 2 * (tt + 1)) {
            const bf16x8 bfr = *(const bf16x8*)(wsb + (size_t)(h4 * 128 + 32 * tt + n) * 128 + 16 * ks + 8 * h);
            acc[tt] = MFMA32(af, bfr, acc[tt]); }
    }
    LAS float* ex = (LAS float*)(lds + 67584);
#pragma unroll
    for (int tt = 0; tt < 4; ++tt) { const int t = 32 * tt + n; const float bias = bs[h4 * 128 + t]; const bf16_t* up = proj + (R0 + t) * INW + 1792 + cbase + 4 * h; float s = 0.f;
#pragma unroll
        for (int g = 0; g < 4; ++g) { const u32x2 uu = *(const u32x2*)(up + 8 * g);
            const float v0 = bflo(uu.x) * (acc[tt][4 * g] + bias), v1 = bfhi(uu.x) * (acc[tt][4 * g + 1] + bias), v2 = bflo(uu.y) * (acc[tt][4 * g + 2] + bias), v3 = bfhi(uu.y) * (acc[tt][4 * g + 3] + bias);
            acc[tt][4 * g] = v0; acc[tt][4 * g + 1] = v1; acc[tt][4 * g + 2] = v2; acc[tt][4 * g + 3] = v3; s += (v0 * v0 + v1 * v1) + (v2 * v2 + v3 * v3); }
        s += __shfl_xor(s, 32);
        if (h == 0) ex[wave * 128 + t] = s; }
    __syncthreads();
#pragma unroll
    for (int tt = 0; tt < 4; ++tt) { const int t = 32 * tt + n; float tot = 0.f;
#pragma unroll
        for (int w8 = 0; w8 < 8; ++w8) tot += ex[w8 * 128 + t];
        const float rstd = __builtin_amdgcn_rsqf(tot * (1.0f / 256.0f) + EPS);
        bf16_t* op = merged + (R0 + t) * D + 768 + cbase + 4 * h; const float* mp = mn + 768 + cbase + 4 * h;
#pragma unroll
        for (int g = 0; g < 4; ++g) { const f32x4 m0 = *(const f32x4*)(mp + 8 * g); u32x2 a0;
            a0.x = cvt_pk_bf16(acc[tt][4 * g] * rstd * m0[0], acc[tt][4 * g + 1] * rstd * m0[1]); a0.y = cvt_pk_bf16(acc[tt][4 * g + 2] * rstd * m0[2], acc[tt][4 * g + 3] * rstd * m0[3]);
            *(u32x2*)(op + 8 * g) = a0; } }
    __syncthreads();
}

__device__ __forceinline__ void pool_unit(int unit, const bf16_t* proj, bf16_t* merged, const float* mn, const bf16_t* wpb, const float* pscale, LAS unsigned char* lds, int tid, int wave, int lane) {
    const size_t T0 = (size_t)unit * 128; const int pos0 = (unit & 63) * 128;
    constexpr int RS = 528;
    for (int c = tid; c < 144 * 32; c += NTHREADS) { const int li = c >> 5, ch = c & 31; u32x4 v = (u32x4){0u, 0u, 0u, 0u};
        if (li >= 16 || pos0 > 0) v = *(const u32x4*)(proj + (T0 + li - 16) * INW + 1536 + 8 * ch);
        *(LAS u32x4*)(lds + li * RS + 16 * ch) = v; }
    __syncthreads();
    const int g = wave >> 1, ttp = wave & 1, n = lane & 31, h = lane >> 5, W = 2 << g;
    f32x16 acc[2][2];
#pragma unroll
    for (int a = 0; a < 2; ++a)
#pragma unroll
        for (int e2 = 0; e2 < 2; ++e2)
#pragma unroll
            for (int i = 0; i < 16; ++i) acc[a][e2][i] = 0.f;
    bf16x8 af[2][4];
#pragma unroll
    for (int e2 = 0; e2 < 2; ++e2)
#pragma unroll
        for (int ks = 0; ks < 4; ++ks) af[e2][ks] = *(const bf16x8*)(wpb + (size_t)(g * 64 + 32 * e2 + n) * 64 + 16 * ks + 8 * h);
#pragma unroll
    for (int a = 0; a < 2; ++a) {
        const int tt = 2 * ttp + a, li = 16 + 32 * tt + n, pos = pos0 + 32 * tt + n; const float inv = 1.0f / (float)min(pos + 1, W);
#pragma unroll
        for (int ks = 0; ks < 4; ++ks) {
            LAS const unsigned char* pb = lds + li * RS + 2 * (64 * g + 16 * ks + 8 * h);
            float sm[8];
#pragma unroll
            for (int k = 0; k < 8; ++k) sm[k] = 0.f;
            for (int j = 0; j < W; ++j) { const u32x4 v = *(LAS const u32x4*)(pb - j * RS);
                sm[0] += bflo(v.x); sm[1] += bfhi(v.x); sm[2] += bflo(v.y); sm[3] += bfhi(v.y); sm[4] += bflo(v.z); sm[5] += bfhi(v.z); sm[6] += bflo(v.w); sm[7] += bfhi(v.w); }
            const u32x4 own = *(LAS const u32x4*)pb; u32x4 p;
            p.x = cvt_pk_bf16(sm[0] * inv - bflo(own.x), sm[1] * inv - bfhi(own.x)); p.y = cvt_pk_bf16(sm[2] * inv - bflo(own.y), sm[3] * inv - bfhi(own.y));
            p.z = cvt_pk_bf16(sm[4] * inv - bflo(own.z), sm[5] * inv - bfhi(own.z)); p.w = cvt_pk_bf16(sm[6] * inv - bflo(own.w), sm[7] * inv - bfhi(own.w));
            const bf16x8 pf = __builtin_bit_cast(bf16x8, p);
            acc[a][0] = MFMA32(af[0][ks], pf, acc[a][0]);
            acc[a][1] = MFMA32(af[1][ks], pf, acc[a][1]);
        }
    }
    LAS float* ex = (LAS float*)(lds + 76032);
#pragma unroll
    for (int a = 0; a < 2; ++a) { float s = 0.f;
#pragma unroll
        for (int e2 = 0; e2 < 2; ++e2)
#pragma unroll
            for (int gg = 0; gg < 4; ++gg) { const f32x4 ps = *(const f32x4*)(pscale + 64 * g + 32 * e2 + 4 * h + 8 * gg);
#pragma unroll
                for (int j = 0; j < 4; ++j) { const float v = acc[a][e2][4 * gg + j] * ps[j]; acc[a][e2][4 * gg + j] = v; s += v * v; } }
        s += __shfl_xor(s, 32);
        if (h == 0) ex[g * 128 + 32 * (2 * ttp + a) + n] = s; }
    __syncthreads();
#pragma unroll
    for (int a = 0; a < 2; ++a) { const int t = 32 * (2 * ttp + a) + n;
        const float tot = (ex[t] + ex[128 + t]) + (ex[256 + t] + ex[384 + t]);
        const float rstd = __builtin_amdgcn_rsqf(tot * (1.0f / 256.0f) + EPS);
#pragma unroll
        for (int e2 = 0; e2 < 2; ++e2) { const int ebase = 64 * g + 32 * e2 + 4 * h;
            bf16_t* op = merged + (T0 + t) * D + 512 + ebase; const float* mp = mn + 512 + ebase;
#pragma unroll
            for (int gg = 0; gg < 4; ++gg) { const f32x4 m0 = *(const f32x4*)(mp + 8 * gg); u32x2 a0;
                a0.x = cvt_pk_bf16(acc[a][e2][4 * gg] * rstd * m0[0], acc[a][e2][4 * gg + 1] * rstd * m0[1]); a0.y = cvt_pk_bf16(acc[a][e2][4 * gg + 2] * rstd * m0[2], acc[a][e2][4 * gg + 3] * rstd * m0[3]);
                *(u32x2*)(op + 8 * gg) = a0; } } }
    __syncthreads();
}

__device__ __forceinline__ void phase_mix(const Args& a, int l, LAS unsigned char* lds) {
    const int tid = opaque_tid(), lane = tid & 63, wave = __builtin_amdgcn_readfirstlane(tid >> 6), G = gridDim.x, bid = opaque_bid();
    const bf16_t* proj = (const bf16_t*)(a.ws + WS_P); bf16_t* merged = (bf16_t*)(a.ws + WS_H);
    const float* mn = a.in[11] + (size_t)l * D;
    { const int per = (M / 32 + G - 1) / G;
      for (int u = bid * per; u < min(M / 32, (bid + 1) * per); ++u) attn_unit(u, proj, merged, mn, lds, wave, lane); }
    __syncthreads();
    { const float* sgn = a.in[8] + l * 256; const bf16_t* wsb = (const bf16_t*)(a.ws + WS_WSB) + (size_t)l * 4 * 128 * 128; const float* bs = a.in[10] + l * 4 * 128;
      for (int u = bid; u < M / 128; u += G) sg_unit(u, proj, merged, mn, sgn, wsb, bs, lds, tid, wave, lane); }
    { const bf16_t* wpb = (const bf16_t*)(a.ws + WS_WPB) + (size_t)l * 4 * 64 * 64; const float* pscale = a.in[7] + l * 256;
      for (int u = bid; u < M / 128; u += G) pool_unit(u, proj, merged, mn, wpb, pscale, lds, tid, wave, lane); }
}
constexpr int N_STEPS = 3 + 5 * DEPTH;
__global__ void __launch_bounds__(NTHREADS, 2) fwd(Args args) {
    extern __shared__ __attribute__((aligned(16))) unsigned char lds_raw[];
    LAS unsigned char* lds = (LAS unsigned char*)lds_raw;
#if MK_ONE_LAUNCH
#define SEAM() grid_bar(bar_ctr, bar_target)
#define SEAM_CG() do { __syncthreads(); cg::this_grid().sync(); } while (0)
#else
#define SEAM() do { } while (0)
#define SEAM_CG() do { } while (0)
#endif
#define RUN(k) (args.ph_lo <= (k) && (k) < args.ph_hi && (k) < MK_MAX_STEP)
    unsigned char* ws = args.ws;
    const float* mod = (const float*)(ws + WS_MOD);
    bf16_t* hbuf = (bf16_t*)(ws + WS_H); bf16_t* pbuf = (bf16_t*)(ws + WS_P);
    unsigned* bar_ctr = (unsigned*)(ws + WS_BAR); unsigned bar_target = 0u; (void)bar_ctr; (void)bar_target;
    if (RUN(0)) phase_pro(args, lds);
    SEAM_CG();
    bf16_t* xbres = (bf16_t*)(ws + WS_XB); bf16_t* xs2 = (bf16_t*)(ws + WS_XS2); float* rsqA = (float*)(ws + WS_RSQA); float* rsqB = (float*)(ws + WS_RSQB);
    if (RUN(1)) { phase_pro2(args); phase_gst(args); phase_norm(args.in[0], args.in[4], mod, mod + 1024, hbuf, xbres); }
    SEAM();
#pragma nounroll
    for (int l = 0; l < DEPTH; ++l) {
        const int s0 = 2 + 5 * l;
        const float* modl = mod + (size_t)l * 8 * NMOD;
        const unsigned char* wl = ws + WS_W + (size_t)l * W_LAYER;
        if (RUN(s0 + 0)) {
            pg8::Gemm g{hbuf, (const bf16_t*)(wl + W_IN_OFF), M, INW, D}; pg8::StaticOrder S; S.init(M, INW, gridDim.x, opaque_bid());
            pg8::EpiProj E{pbuf, l == 0 ? nullptr : rsqB, (const float*)(ws + WS_SHW1) + (size_t)l * 8 * INW};
            pg8::gemm_phase<pg8::EpiProj, pg8::StaticOrder, true, true>(lds, g, S, E); }
        SEAM();
        if (RUN(s0 + 1)) phase_mix(args, l, lds);
        SEAM();
        if (RUN(s0 + 2)) { pg8::Gemm g{hbuf, (const bf16_t*)(wl + W_OUT_OFF), M, D, D}; pg8::StaticOrder S; S.init(M, D, gridDim.x, opaque_bid());
            pg8::EpiRes E{xbres, modl + 2048, xs2, rsqA, (const float*)(ws + WS_GST) + (size_t)(l * 2 + 1) * 8 * D, (LAS float*)(lds + 131072)};
            pg8::gemm_phase<pg8::EpiRes, pg8::StaticOrder, true, true>(lds, g, S, E); }
        SEAM();
        if (RUN(s0 + 3)) {
            pg8::Gemm g{xs2, (const bf16_t*)(wl + W_GU_OFF), M, GU, D}; pg8::StaticOrder S; S.init(M, GU, gridDim.x, opaque_bid());
            pg8::EpiSwiglu E{pbuf, rsqA, (const float*)(ws + WS_SHW2) + (size_t)l * 8 * GU};
            pg8::gemm_phase<pg8::EpiSwiglu, pg8::StaticOrder, true, true>(lds, g, S, E); }
        SEAM();
        if (RUN(s0 + 4)) { const bool last = (l == DEPTH - 1); const int ln = last ? l : l + 1;
            pg8::Gemm g{pbuf, (const bf16_t*)(wl + W_DN_OFF), M, D, FF}; pg8::StaticOrder S; S.init(M, D, gridDim.x, opaque_bid());
            pg8::EpiRes E{xbres, modl + 5120, last ? nullptr : hbuf, rsqB, (const float*)(ws + WS_GST) + (size_t)(ln * 2) * 8 * D, (LAS float*)(lds + 131072)};
            pg8::gemm_phase<pg8::EpiRes, pg8::StaticOrder, true, true>(lds, g, S, E); }
        SEAM();
    }
    if (RUN(N_STEPS - 1)) phase_final(xbres, args.in[16], args.out);
#undef RUN
#undef SEAM
#undef SEAM_CG
}

extern "C" void kernel_launch(void* const* d_in, const int* in_sizes, int n_in, void* d_out, int out_size, void* d_ws, size_t ws_size, hipStream_t stream) {
    static int grid = 0;
    if (grid == 0) {
        if (n_in != 17 || in_sizes[0] != M * D || out_size != M * D || ws_size < WS_END2) { fprintf(stderr, "kernel_launch: unexpected shapes (n_in %d in0 %d out %d ws %zu)\n", n_in, n_in > 0 ? in_sizes[0] : -1, out_size, ws_size); grid = -1; return; }
        int dev = 0, cus = 0, per_cu = 0;
        if (hipGetDevice(&dev) != hipSuccess || hipDeviceGetAttribute(&cus, hipDeviceAttributeMultiprocessorCount, dev) != hipSuccess) { grid = -1; return; }
        if (hipFuncSetAttribute((const void*)fwd, hipFuncAttributeMaxDynamicSharedMemorySize, LDS_BYTES) != hipSuccess) { fprintf(stderr, "kernel_launch: hipFuncSetAttribute failed\n"); grid = -1; return; }
        if (hipOccupancyMaxActiveBlocksPerMultiprocessor(&per_cu, (const void*)fwd, NTHREADS, LDS_BYTES) != hipSuccess || per_cu < 1) { fprintf(stderr, "kernel_launch: occupancy query gave %d\n", per_cu); per_cu = 1; }
        (void)hipGetLastError();
        grid = cus * per_cu;
    }
    if (grid < 0) return;
    Args a{};
    for (int i = 0; i < 17; ++i) a.in[i] = (const float*)d_in[i];
    a.out = (float*)d_out; a.ws = (unsigned char*)d_ws;
#if MK_ONE_LAUNCH
    if (hipMemsetAsync((char*)d_ws + WS_BAR, 0, 256, stream) != hipSuccess) { fprintf(stderr, "kernel_launch: memset failed\n"); return; }
    a.ph_lo = 0; a.ph_hi = N_STEPS;
    void* params[] = {&a};
    hipError_t e = hipLaunchCooperativeKernel((const void*)fwd, dim3(grid), dim3(NTHREADS), params, LDS_BYTES, stream);
    if (e != hipSuccess) fprintf(stderr, "cooperative launch failed: %s (grid %d)\n", hipGetErrorString(e), grid);
#else
    for (int k = 0; k < N_STEPS && k < (MK_MAX_STEP > 0 ? MK_MAX_STEP : 1); ++k) { a.ph_lo = k; a.ph_hi = k + 1; hipLaunchKernelGGL(fwd, dim3(grid), dim3(NTHREADS), LDS_BYTES, stream, a); }
#endif
}
```

```cpp
#include <hip/hip_runtime.h>
#include <hip/hip_cooperative_groups.h>
#include <cstdio>
#include <cstdint>
namespace cg = cooperative_groups;
#ifndef MK_MAX_STEP
#define MK_MAX_STEP 100
#define MK_PRO_MASK 7
#endif
#ifndef MK_ONE_LAUNCH
#define MK_ONE_LAUNCH 1
#endif
__device__ __forceinline__ int opaque_tid() { int t = threadIdx.x; asm volatile("" : "+v"(t)); return t; }
__device__ __forceinline__ int opaque_bid() { int b = blockIdx.x; asm volatile("" : "+s"(b)); return b; }
namespace pg8 {
#define PG8_LAS __attribute__((address_space(3)))
typedef unsigned short bf16_t;
typedef short bf16x8 __attribute__((ext_vector_type(8)));
typedef float f32x4 __attribute__((ext_vector_type(4)));
typedef unsigned u32x4 __attribute__((ext_vector_type(4)));
constexpr int BM = 256, BK = 64, HALF = 128, HTB = HALF * BK * 2  , STAGE_BYTES = 8 * HTB, NXCD = 8, WGM = 8;

__host__ __device__ __forceinline__ int lds_byte(int r, int c) { const int st = (r >> 4) * 2 + (c >> 5), rr = r & 15, cc = c & 31, ob = rr * 64 + cc * 2; return st * 1024 + (ob ^ (((ob >> 9) & 1) << 5)); }
__host__ __device__ __forceinline__ void stage_rc(int b, int& R, int& C) { const int st = b / 1024, sb = b % 1024, swz = sb ^ (((sb >> 9) & 1) << 5); R = (st >> 1) * 16 + swz / 64; C = (st & 1) * 32 + (swz % 64) / 2; }
__host__ __device__ __forceinline__ int perm32(int rho) { const int n = rho >> 4, i = rho & 15; return 8 * (i >> 2) + 4 * n + (i & 3); }

struct Unit { int pm, pn; };
struct Gemm { const bf16_t* A; const bf16_t* Bt; int M, N, K; };

struct StaticOrder {
    int nM, nN, nwg, G, c, rev;
    __host__ __device__ void init(int M, int N, int G_, int c_, int rev_ = 0) { nM = M / BM; nN = N / BM; nwg = nM * nN; G = G_; c = c_; rev = rev_; }
    __host__ __device__ bool next(int i, Unit& u) const {
        const int nr = (nwg + G - 1) / G; if (i >= nr) return false;
        const long L = (long)(rev ? nr - 1 - i : i) * G + c; if (L >= nwg) return false;
        int wgid = (int)L; { const int q = nwg / NXCD, r = nwg % NXCD, xcd = wgid % NXCD, off = wgid / NXCD; wgid = (xcd < r ? xcd * (q + 1) : r * (q + 1) + (xcd - r) * q) + off; }
        const int nig = WGM * nN, gid = wgid / nig, fm = gid * WGM, gsz = (nM - fm) < WGM ? (nM - fm) : WGM;
        u.pm = fm + ((wgid % nig) % gsz); u.pn = (wgid % nig) / gsz; return true;
    }
    __device__ __forceinline__ void a_ready(const Unit&) const {}
    __device__ __forceinline__ void done(const Unit&) const {}
};

typedef unsigned u32x2 __attribute__((ext_vector_type(2)));
typedef float f32x2 __attribute__((ext_vector_type(2)));
typedef __bf16 bf16x2_t __attribute__((ext_vector_type(2)));
__device__ __forceinline__ unsigned cvt_pk_bf16(float lo, float hi) { f32x2 v = {lo, hi}; bf16x2_t b = __builtin_convertvector(v, bf16x2_t); return __builtin_bit_cast(unsigned, b); }
__device__ __forceinline__ float fast_sigmoid(float x) { return __builtin_amdgcn_rcpf(1.0f + __builtin_amdgcn_exp2f(-1.4426950408889634f * x)); }
__device__ __forceinline__ float gelu_tanh(float x) { const float u = 0.7978845608028654f * (x + 0.044715f * x * x * x); return x * fast_sigmoid(2.0f * u); }
__device__ __forceinline__ float silu_f(float x) { return x * fast_sigmoid(x); }

struct EpiProj {
    static constexpr bool PERM = true, AFTER_DRAIN = false;
    bf16_t* O; const float* rowsq; const float* shw;
    __device__ __forceinline__ void operator()(const f32x4 (&acc)[2][2][4][2], const Unit& u, int wr, int wc, int fr, int fq) const {
        const int row0 = u.pm * BM + wr * 64 + fr, col0 = u.pn * BM + wc * 32 + 8 * fq; const bool act = u.pn >= 7;
        f32x4 bv[2][2];
#pragma unroll
        for (int bj = 0; bj < 2; ++bj)
#pragma unroll
            for (int n = 0; n < 2; ++n) bv[bj][n] = rowsq ? *(const f32x4*)(shw + (size_t)(u.pm >> 5) * 2304 + col0 + bj * HALF + 4 * n) : (f32x4){0.f, 0.f, 0.f, 0.f};
        float rsv[2][4];
#pragma unroll
        for (int ai = 0; ai < 2; ++ai)
#pragma unroll
            for (int m = 0; m < 4; ++m) { const int r_ = row0 + ai * HALF + m * 16; rsv[ai][m] = rowsq ? (rowsq[r_] + rowsq[65536 + r_]) + (rowsq[131072 + r_] + rowsq[196608 + r_]) : 0.f; }
#pragma unroll
        for (int ai = 0; ai < 2; ++ai)
#pragma unroll
            for (int m = 0; m < 4; ++m) { bf16_t* rowp = O + (size_t)(row0 + ai * HALF + m * 16) * 2304 + col0;
                const float rs = rowsq ? __builtin_amdgcn_rsqf(rsv[ai][m] * (1.0f / 1024.0f) + 1e-6f) : 1.0f;
#pragma unroll
                for (int bj = 0; bj < 2; ++bj) { f32x4 v0 = acc[ai][bj][m][0] * rs + bv[bj][0], v1 = acc[ai][bj][m][1] * rs + bv[bj][1];
                    if (act) { v0 = (f32x4){gelu_tanh(v0[0]), gelu_tanh(v0[1]), gelu_tanh(v0[2]), gelu_tanh(v0[3])}; v1 = (f32x4){gelu_tanh(v1[0]), gelu_tanh(v1[1]), gelu_tanh(v1[2]), gelu_tanh(v1[3])}; }
                    u32x4 w; w.x = cvt_pk_bf16(v0[0], v0[1]); w.y = cvt_pk_bf16(v0[2], v0[3]); w.z = cvt_pk_bf16(v1[0], v1[1]); w.w = cvt_pk_bf16(v1[2], v1[3]);
                    *(u32x4*)(rowp + bj * HALF) = w; } }
    }
};
struct EpiSwiglu {
    static constexpr bool PERM = true, AFTER_DRAIN = false;
    bf16_t* O; const float* rowsq; const float* shw;
    __device__ __forceinline__ void operator()(const f32x4 (&acc)[2][2][4][2], const Unit& u, int wr, int wc, int fr, int fq) const {
        const int row0 = u.pm * BM + wr * 64 + fr, col0 = u.pn * HALF + wc * 32 + 8 * fq;
        const float* sp = shw + (size_t)(u.pm >> 5) * 5632 + u.pn * BM + wc * 32 + 8 * fq;
        const f32x4 bg0 = *(const f32x4*)(sp), bg1 = *(const f32x4*)(sp + 4), bu0 = *(const f32x4*)(sp + HALF), bu1 = *(const f32x4*)(sp + HALF + 4);
        float rsv[2][4];
#pragma unroll
        for (int ai = 0; ai < 2; ++ai)
#pragma unroll
            for (int m = 0; m < 4; ++m) { const int r_ = row0 + ai * HALF + m * 16; rsv[ai][m] = (rowsq[r_] + rowsq[65536 + r_]) + (rowsq[131072 + r_] + rowsq[196608 + r_]); }
#pragma unroll
        for (int ai = 0; ai < 2; ++ai)
#pragma unroll
            for (int m = 0; m < 4; ++m) { bf16_t* rowp = O + (size_t)(row0 + ai * HALF + m * 16) * 2816 + col0;
                const float rs = __builtin_amdgcn_rsqf(rsv[ai][m] * (1.0f / 1024.0f) + 1e-6f);
                const f32x4 g0 = acc[ai][0][m][0] * rs + bg0, g1 = acc[ai][0][m][1] * rs + bg1, u0 = acc[ai][1][m][0] * rs + bu0, u1 = acc[ai][1][m][1] * rs + bu1;
                u32x4 w; w.x = cvt_pk_bf16(silu_f(g0[0]) * u0[0], silu_f(g0[1]) * u0[1]); w.y = cvt_pk_bf16(silu_f(g0[2]) * u0[2], silu_f(g0[3]) * u0[3]);
                w.z = cvt_pk_bf16(silu_f(g1[0]) * u1[0], silu_f(g1[1]) * u1[1]); w.w = cvt_pk_bf16(silu_f(g1[2]) * u1[2], silu_f(g1[3]) * u1[3]);
                *(u32x4*)rowp = w; }
    }
};
struct EpiRes {
    static constexpr bool PERM = true, AFTER_DRAIN = false;
    bf16_t* x; const float* gate; bf16_t* xs; float* rowsq; const float* gst; PG8_LAS float* sl;
    __device__ __forceinline__ void operator()(f32x4 (&acc)[2][2][4][2], const Unit& u, int wr, int wc, int fr, int fq) const {
        const int col0 = u.pn * BM + wc * 32 + 8 * fq; const float* gp = gate + (size_t)(u.pm >> 5) * 6144 + col0;
        const size_t base = (size_t)(u.pm * BM + wr * 64 + fr) * 1024 + col0;
        u32x4 xb[3][2];
#define EPIRES_LOAD(G) do { _Pragma("unroll") for (int bj_ = 0; bj_ < 2; ++bj_) \
            xb[(G) % 3][bj_] = *(const u32x4*)(x + base + (size_t)(((G) >> 2) * HALF + ((G) & 3) * 16) * 1024 + bj_ * HALF); } while (0)
        EPIRES_LOAD(0); EPIRES_LOAD(1);
        f32x4 gs[2][2];
        { f32x4 gv[2][2];
#pragma unroll
          for (int bj = 0; bj < 2; ++bj)
#pragma unroll
              for (int n = 0; n < 2; ++n) { gv[bj][n] = *(const f32x4*)(gp + bj * HALF + 4 * n);
                  gs[bj][n] = xs ? *(const f32x4*)(gst + (size_t)(u.pm >> 5) * 1024 + col0 + bj * HALF + 4 * n) : (f32x4){0.f, 0.f, 0.f, 0.f}; }
#pragma unroll
          for (int ai = 0; ai < 2; ++ai)
#pragma unroll
              for (int bj = 0; bj < 2; ++bj)
#pragma unroll
                  for (int m = 0; m < 4; ++m)
#pragma unroll
                      for (int n = 0; n < 2; ++n) acc[ai][bj][m][n] *= gv[bj][n]; }
#pragma unroll
        for (int g = 0; g < 8; ++g) { const int ai = g >> 2, m = g & 3;
            if (g + 2 < 8) EPIRES_LOAD(g + 2);
            const int row = u.pm * BM + ai * HALF + wr * 64 + m * 16 + fr; const size_t off = (size_t)row * 1024 + col0; float ssq = 0.f;
#pragma unroll
            for (int bj = 0; bj < 2; ++bj) { const u32x4 xr = xb[g % 3][bj];
                const f32x4 o0 = (f32x4){__uint_as_float(xr.x << 16), __uint_as_float(xr.x & 0xffff0000u), __uint_as_float(xr.y << 16), __uint_as_float(xr.y & 0xffff0000u)} + acc[ai][bj][m][0];
                const f32x4 o1 = (f32x4){__uint_as_float(xr.z << 16), __uint_as_float(xr.z & 0xffff0000u), __uint_as_float(xr.w << 16), __uint_as_float(xr.w & 0xffff0000u)} + acc[ai][bj][m][1];
                u32x4 w; w.x = cvt_pk_bf16(o0[0], o0[1]); w.y = cvt_pk_bf16(o0[2], o0[3]); w.z = cvt_pk_bf16(o1[0], o1[1]); w.w = cvt_pk_bf16(o1[2], o1[3]);
                *(u32x4*)(x + off + bj * HALF) = w;
                if (xs) { ssq += ((o0[0] * o0[0] + o0[1] * o0[1]) + (o0[2] * o0[2] + o0[3] * o0[3])) + ((o1[0] * o1[0] + o1[1] * o1[1]) + (o1[2] * o1[2] + o1[3] * o1[3]));
                    const f32x4 y0 = o0 * gs[bj][0], y1 = o1 * gs[bj][1];
                    u32x4 v; v.x = cvt_pk_bf16(y0[0], y0[1]); v.y = cvt_pk_bf16(y0[2], y0[3]); v.z = cvt_pk_bf16(y1[0], y1[1]); v.w = cvt_pk_bf16(y1[2], y1[3]);
                    *(u32x4*)(xs + off + bj * HALF) = v; } }
            if (xs) { ssq += __shfl_xor(ssq, 16); ssq += __shfl_xor(ssq, 32);
                if (fq == 0) sl[wc * 256 + ai * HALF + wr * 64 + m * 16 + fr] = ssq; } }
#undef EPIRES_LOAD
        if (xs) {
            asm volatile("s_waitcnt lgkmcnt(0)" ::: "memory"); __builtin_amdgcn_s_barrier(); asm volatile("" ::: "memory");
            const int t = (wr * 4 + wc) * 64 + fq * 16 + fr;
            if (t < 256) rowsq[(size_t)u.pn * 65536 + u.pm * BM + t] = (sl[t] + sl[256 + t]) + (sl[512 + t] + sl[768 + t]);
        }
    }
};
template <class Epi, class Sched, bool ALIGN_EPI = false, bool SP2 = false>
__device__ __forceinline__ void gemm_phase(PG8_LAS unsigned char* lds, const Gemm g, const Sched& S, const Epi& E) {
    const int tid = opaque_tid(), wid = __builtin_amdgcn_readfirstlane(tid >> 6), lane = tid & 63, wr = wid >> 2, wc = wid & 3, fr = lane & 15, fq = lane >> 4;
    const int K = g.K, nt = K / BK;
    unsigned voffA[2], voffB[2];
#pragma unroll
    for (int i = 0; i < 2; ++i) { int R, C; stage_rc(tid * 16 + i * 8192, R, C); const int Rb = Epi::PERM ? ((R & ~31) + perm32(R & 31)) : R;
        voffA[i] = (unsigned)(R * K + C) * 2u; voffB[i] = (unsigned)(Rb * K + C) * 2u; }
    const size_t kstep = (size_t)(BK * 2);
    const size_t hstep = (size_t)HALF * K * 2;
    const size_t tstep = 2 * hstep;
    const unsigned ldsw = (unsigned)wid * 1024u;
    const int aoff = lds_byte(wr * 64 + fr, fq * 8), boff = lds_byte(wc * 32 + fr, fq * 8);
#define PG8_SA(b, h) (((b) * 2 + (h)) * HTB)
#define PG8_SB(b, h) ((4 + (b) * 2 + (h)) * HTB)
#define PG8_STAGE(bufoff, gbase, voff) do { _Pragma("unroll") for (int _i = 0; _i < 2; ++_i) \
        __builtin_amdgcn_global_load_lds((const unsigned*)((const char*)(gbase) + (voff)[_i]), (PG8_LAS unsigned*)(lds + (bufoff) + ldsw + _i * 8192), 16, 0, 0); } while (0)
#define PG8_LDA(dst, b, h) do { _Pragma("unroll") for (int m = 0; m < 4; ++m) _Pragma("unroll") for (int k = 0; k < 2; ++k) dst[m][k] = *(const PG8_LAS bf16x8*)(lds + PG8_SA(b, h) + aoff + m * 2048 + k * 1024); } while (0)
#define PG8_LDB(dst, b, h) do { _Pragma("unroll") for (int n = 0; n < 2; ++n) _Pragma("unroll") for (int k = 0; k < 2; ++k) dst[n][k] = *(const PG8_LAS bf16x8*)(lds + PG8_SB(b, h) + boff + n * 2048 + k * 1024); } while (0)
#define PG8_MMA(ai, bj, At, Bt) do { __builtin_amdgcn_s_setprio(1); _Pragma("unroll") for (int m = 0; m < 4; ++m) _Pragma("unroll") for (int n = 0; n < 2; ++n) _Pragma("unroll") for (int k = 0; k < 2; ++k) \
        acc[ai][bj][m][n] = __builtin_amdgcn_mfma_f32_16x16x32_bf16(Bt[n][k], At[m][k], acc[ai][bj][m][n], 0, 0, 0); __builtin_amdgcn_s_setprio(0); } while (0)
#define PG8_WAIT_V(n) asm volatile("s_waitcnt vmcnt(" #n ")" ::: "memory")
#define PG8_WAIT_L(n) asm volatile("s_waitcnt lgkmcnt(" #n ")" ::: "memory")
#define PG8_BAR __builtin_amdgcn_s_barrier()
#define PG8_SCHED __builtin_amdgcn_sched_barrier(0)
    Unit cur, nxt; int ui = 0;
    if (!S.next(0, cur)) return;
    f32x4 acc[2][2][4][2];
#pragma unroll
    for (int a = 0; a < 2; ++a)
#pragma unroll
        for (int b = 0; b < 2; ++b)
#pragma unroll
            for (int m = 0; m < 4; ++m)
#pragma unroll
                for (int n = 0; n < 2; ++n) acc[a][b][m][n] = (f32x4){0.f, 0.f, 0.f, 0.f};
    bf16x8 At[4][2], B0[2][2], B1[2][2];
    const char* cA = (const char*)g.A + (size_t)cur.pm * tstep; const char* cB = (const char*)g.Bt + (size_t)cur.pn * tstep;
    S.a_ready(cur);
    if constexpr (SP2) {
        PG8_STAGE(PG8_SB(0, 0), cB, voffB); PG8_STAGE(PG8_SB(0, 1), cB + hstep, voffB); PG8_STAGE(PG8_SA(0, 0), cA, voffA); PG8_STAGE(PG8_SA(0, 1), cA + hstep, voffA);
        if (wr == 1) PG8_BAR;
        PG8_WAIT_V(2); PG8_BAR;
        PG8_STAGE(PG8_SB(1, 0), cB + kstep, voffB); PG8_STAGE(PG8_SA(1, 0), cA + kstep, voffA); PG8_STAGE(PG8_SB(1, 1), cB + hstep + kstep, voffB);
        PG8_WAIT_V(6); PG8_BAR;
    } else {
        PG8_STAGE(PG8_SB(0, 0), cB, voffB); PG8_STAGE(PG8_SA(0, 0), cA, voffA); PG8_STAGE(PG8_SB(0, 1), cB + hstep, voffB); PG8_STAGE(PG8_SA(0, 1), cA + hstep, voffA);
        if (wr == 1) PG8_BAR;
        PG8_WAIT_V(4); PG8_BAR;
        PG8_STAGE(PG8_SB(1, 0), cB + kstep, voffB); PG8_STAGE(PG8_SA(1, 0), cA + kstep, voffA); PG8_STAGE(PG8_SB(1, 1), cB + hstep + kstep, voffB);
        PG8_WAIT_V(6); PG8_BAR;
    }
    for (;;) {
        const bool has_next = S.next(ui + 1, nxt);
        const char* nA = has_next ? (const char*)g.A + (size_t)nxt.pm * tstep : cA; const char* nB = has_next ? (const char*)g.Bt + (size_t)nxt.pn * tstep : cB;
        for (int t = 0; t < nt; t += 2) {
            const bool last = (t == nt - 2);
            const char* a1 = cA + (size_t)(t + 1) * kstep;
            const char* a2 = last ? nA : cA + (size_t)(t + 2) * kstep; const char* b2 = last ? nB : cB + (size_t)(t + 2) * kstep;
            const char* a3 = a2 + kstep; const char* b3 = b2 + kstep;
            if (last && has_next) S.a_ready(nxt);
            if constexpr (SP2) {
            PG8_LDB(B0, 0, 0); PG8_LDB(B1, 0, 1); PG8_SCHED; PG8_LDA(At, 0, 0); PG8_STAGE(PG8_SA(1, 1), a1 + hstep, voffA);
            PG8_WAIT_V(8); PG8_WAIT_L(0); PG8_BAR; PG8_MMA(0, 0, At, B0); PG8_MMA(0, 1, At, B1); PG8_BAR; PG8_SCHED;
            PG8_LDA(At, 0, 1); PG8_STAGE(PG8_SB(0, 0), b2, voffB); PG8_STAGE(PG8_SB(0, 1), b2 + hstep, voffB); PG8_STAGE(PG8_SA(0, 0), a2, voffA);
            PG8_WAIT_V(8); PG8_WAIT_L(0); PG8_BAR; PG8_MMA(1, 0, At, B0); PG8_MMA(1, 1, At, B1); PG8_BAR; PG8_SCHED;
            PG8_LDB(B0, 1, 0); PG8_LDB(B1, 1, 1); PG8_SCHED; PG8_LDA(At, 1, 0); PG8_STAGE(PG8_SA(0, 1), a2 + hstep, voffA);
            PG8_WAIT_V(8); PG8_WAIT_L(0); PG8_BAR; PG8_MMA(0, 0, At, B0); PG8_MMA(0, 1, At, B1); PG8_BAR; PG8_SCHED;
            PG8_LDA(At, 1, 1); PG8_STAGE(PG8_SB(1, 0), b3, voffB); PG8_STAGE(PG8_SB(1, 1), b3 + hstep, voffB); PG8_STAGE(PG8_SA(1, 0), a3, voffA);
            PG8_WAIT_V(8); PG8_WAIT_L(0); PG8_BAR; PG8_MMA(1, 0, At, B0); PG8_MMA(1, 1, At, B1); PG8_BAR; PG8_SCHED;
            } else {
            PG8_LDB(B0, 0, 0); PG8_SCHED; PG8_LDA(At, 0, 0); PG8_STAGE(PG8_SA(1, 1), a1 + hstep, voffA);
            PG8_WAIT_L(8); PG8_BAR; PG8_WAIT_L(0); PG8_MMA(0, 0, At, B0); PG8_BAR; PG8_SCHED;
            PG8_LDB(B1, 0, 1); PG8_STAGE(PG8_SB(0, 0), b2, voffB);
            PG8_BAR; PG8_WAIT_L(0); PG8_MMA(0, 1, At, B1); PG8_BAR;
            PG8_LDA(At, 0, 1); PG8_STAGE(PG8_SA(0, 0), a2, voffA);
            PG8_BAR; PG8_WAIT_L(0); PG8_MMA(1, 0, At, B0); PG8_BAR; PG8_SCHED;
            PG8_STAGE(PG8_SB(0, 1), b2 + hstep, voffB);
            PG8_WAIT_V(6); PG8_BAR; PG8_MMA(1, 1, At, B1); PG8_BAR;
            PG8_LDB(B0, 1, 0); PG8_SCHED; PG8_LDA(At, 1, 0); PG8_STAGE(PG8_SA(0, 1), a2 + hstep, voffA);
            PG8_WAIT_L(8); PG8_BAR; PG8_WAIT_L(0); PG8_MMA(0, 0, At, B0); PG8_BAR; PG8_SCHED;
            PG8_LDB(B1, 1, 1); PG8_STAGE(PG8_SB(1, 0), b3, voffB);
            PG8_BAR; PG8_WAIT_L(0); PG8_MMA(0, 1, At, B1); PG8_BAR;
            PG8_LDA(At, 1, 1); PG8_STAGE(PG8_SA(1, 0), a3, voffA);
            PG8_BAR; PG8_WAIT_L(0); PG8_MMA(1, 0, At, B0); PG8_BAR; PG8_SCHED;
            PG8_STAGE(PG8_SB(1, 1), b3 + hstep, voffB);
            PG8_WAIT_V(6); PG8_BAR; PG8_MMA(1, 1, At, B1); PG8_BAR;
            }
        }
        if constexpr (ALIGN_EPI) { if (wr == 0) PG8_BAR; }
        if constexpr (!Epi::AFTER_DRAIN) { E(acc, cur, wr, wc, fr, fq); S.done(cur); }
        if (!has_next) break;
#pragma unroll
        for (int a = 0; a < 2; ++a)
#pragma unroll
            for (int b = 0; b < 2; ++b)
#pragma unroll
                for (int m = 0; m < 4; ++m)
#pragma unroll
                    for (int n = 0; n < 2; ++n) acc[a][b][m][n] = (f32x4){0.f, 0.f, 0.f, 0.f};
        cur = nxt; cA = nA; cB = nB; ++ui;
        if constexpr (ALIGN_EPI) { if (wr == 1) PG8_BAR; }
    }
    PG8_WAIT_V(0);
    if constexpr (!ALIGN_EPI) { if (wr == 0) PG8_BAR; }
    PG8_BAR;
    if constexpr (Epi::AFTER_DRAIN) { E.fused(acc, cur, wr, wc, fr, fq, lds, wid, lane); S.done(cur); }
#undef PG8_SA
#undef PG8_SB
#undef PG8_STAGE
#undef PG8_LDA
#undef PG8_LDB
#undef PG8_MMA
#undef PG8_WAIT_V
#undef PG8_WAIT_L
#undef PG8_BAR
#undef PG8_SCHED
}
}
#define LAS __attribute__((address_space(3)))
typedef unsigned short bf16_t;
typedef short bf16x8 __attribute__((ext_vector_type(8)));
typedef short s16x4 __attribute__((ext_vector_type(4)));
typedef float f32x4 __attribute__((ext_vector_type(4)));
typedef float f32x16 __attribute__((ext_vector_type(16)));
typedef unsigned u32x4 __attribute__((ext_vector_type(4)));
typedef unsigned u32x2 __attribute__((ext_vector_type(2)));
using pg8::cvt_pk_bf16;
constexpr int NB = 8, SEQ = 8192, D = 1024, M = NB * SEQ, INW = 2304, FF = 2816, GU = 2 * FF, DEPTH = 4, NMOD = 6144;
constexpr float EPS = 1e-6f;
constexpr size_t MiB = 1u << 20;
constexpr size_t WS_MOD = 0;
constexpr size_t WS_WSB = 1 * MiB;
constexpr size_t WS_WPB = WS_WSB + 512 * 1024;
constexpr size_t WS_W = 2 * MiB;
constexpr size_t W_IN_OFF = 0, W_OUT_OFF = 5 * MiB, W_GU_OFF = 7 * MiB, W_DN_OFF = 18 * MiB, W_LAYER = 23 * MiB + 512 * 1024;
constexpr size_t WS_H = 96 * MiB;
constexpr size_t WS_P = 224 * MiB;
constexpr size_t WS_END = 576 * MiB;
constexpr size_t WS_SHW1 = 577 * MiB;
constexpr size_t WS_SHW2 = 578 * MiB;
constexpr size_t WS_RSQA = 836 * MiB, WS_RSQB = 837 * MiB;
constexpr size_t WS_XS2 = 580 * MiB;
constexpr size_t WS_XB = 708 * MiB;
constexpr size_t WS_END2 = 838 * MiB;
constexpr size_t WS_GST = 576 * MiB + 512 * 1024;
constexpr size_t WS_BAR = WS_END;
static_assert(WS_W + 4 * W_LAYER <= WS_H && WS_H + (size_t)M * D * 2 <= WS_P && WS_P + (size_t)M * FF * 2 <= WS_END, "ws map");
constexpr int LDS_BYTES = 147456;
constexpr int NTHREADS = 512;

__device__ __forceinline__ void grid_bar(unsigned* ctr, unsigned& target) {
    target += gridDim.x;
    asm volatile("s_waitcnt vmcnt(0)" ::: "memory");
    __syncthreads();
    if (threadIdx.x == 0) {
        __builtin_amdgcn_fence(__ATOMIC_RELEASE, "agent");
        asm volatile("s_waitcnt vmcnt(0)" ::: "memory");
        __hip_atomic_fetch_add(ctr, 1u, __ATOMIC_RELAXED, __HIP_MEMORY_SCOPE_AGENT);
        while (__hip_atomic_load(ctr, __ATOMIC_RELAXED, __HIP_MEMORY_SCOPE_AGENT) < target) __builtin_amdgcn_s_sleep(1);
        __builtin_amdgcn_fence(__ATOMIC_ACQUIRE, "agent");
        asm volatile("s_waitcnt vmcnt(0)" ::: "memory");
    }
    __syncthreads();
}
struct Args { const float* in[17]; float* out; unsigned char* ws; int ph_lo, ph_hi; };

__device__ __forceinline__ float wave_sum(float v) {
#pragma unroll
    for (int o = 1; o < 64; o <<= 1) v += __shfl_xor(v, o);
    return v;
}
__device__ __forceinline__ float bf2f(unsigned short b) { return __uint_as_float((unsigned)b << 16); }
__device__ __forceinline__ float bflo(unsigned w) { return __uint_as_float(w << 16); }
__device__ __forceinline__ float bfhi(unsigned w) { return __uint_as_float(w & 0xffff0000u); }
__device__ __forceinline__ int crow(int reg, int h) { return (reg & 3) + 8 * (reg >> 2) + 4 * h; }
#define MFMA32(a, b, c) __builtin_amdgcn_mfma_f32_32x32x16_bf16((a), (b), (c), 0, 0, 0)
typedef short v4i16_t __attribute__((ext_vector_type(4)));
__device__ __forceinline__ s16x4 vtr(LAS const unsigned char* p) { return __builtin_bit_cast(s16x4, __builtin_amdgcn_ds_read_tr16_b64_v4i16((LAS v4i16_t*)p)); }
__device__ __forceinline__ bf16x8 cat8(s16x4 lo, s16x4 hi) { return __builtin_shufflevector(lo, hi, 0, 1, 2, 3, 4, 5, 6, 7); }

__device__ __forceinline__ void phase_pro(const Args& a, LAS unsigned char* lds) {
    const int tid = opaque_tid(), G = gridDim.x, bid = opaque_bid();
    LAS float* sc = (LAS float*)lds; LAS float* red = (LAS float*)(lds + 32768);
    { const float* c = a.in[1];
      for (int i = tid; i < NB * D; i += NTHREADS) { const float v = c[i]; sc[i] = v * pg8::fast_sigmoid(v); } }
    __syncthreads();
    float* mod = (float*)(a.ws + WS_MOD);
    if (MK_PRO_MASK & 1)
    for (int item = bid; item < DEPTH * 192; item += G) {
        const int l = item / 192, cgp = item % 192, kp = tid >> 3, n4 = tid & 7;
        float acc[8][4];
#pragma unroll
        for (int b = 0; b < 8; ++b)
#pragma unroll
            for (int j = 0; j < 4; ++j) acc[b][j] = 0.f;
        const float* wp = a.in[2] + ((size_t)l * D + kp * 16) * NMOD + cgp * 32 + n4 * 4;
#pragma unroll 4
        for (int k = 0; k < 16; ++k) {
            const f32x4 w = *(const f32x4*)(wp + (size_t)k * NMOD);
#pragma unroll
            for (int b = 0; b < 8; ++b) { const float s = sc[b * D + kp * 16 + k]; acc[b][0] += s * w[0]; acc[b][1] += s * w[1]; acc[b][2] += s * w[2]; acc[b][3] += s * w[3]; }
        }
#pragma unroll
        for (int b = 0; b < 8; ++b)
#pragma unroll
            for (int j = 0; j < 4; ++j) red[(kp * 8 + b) * 32 + n4 * 4 + j] = acc[b][j];
        __syncthreads();
        if (tid < 256) { const int b = tid >> 5, col = tid & 31; float s = 0.f;
            for (int k2 = 0; k2 < 64; ++k2) s += red[(k2 * 8 + b) * 32 + col];
            mod[(size_t)(l * 8 + b) * NMOD + cgp * 32 + col] = s + a.in[3][l * NMOD + cgp * 32 + col]; }
        __syncthreads();
    }
    LAS float* tile = (LAS float*)lds;
    if (MK_PRO_MASK & 2)
    for (int it = bid; it < DEPTH * 2944; it += G) {
        const int l = it / 2944; int r = it % 2944;
        const float* W; int K, N, kt, nt, kind = 0; size_t woff;
        if (r < 576) { W = a.in[5] + (size_t)l * D * INW; K = D; N = INW; kt = r / 36; nt = r % 36; woff = W_IN_OFF; }
        else if (r < 832) { r -= 576; W = a.in[12] + (size_t)l * D * D; K = D; N = D; kt = r / 16; nt = r % 16; woff = W_OUT_OFF; }
        else if (r < 2240) { r -= 832; W = a.in[14] + (size_t)l * D * GU; K = D; N = GU; kt = r / 88; nt = r % 88; woff = W_GU_OFF; kind = 1; }
        else { r -= 2240; W = a.in[15] + (size_t)l * FF * D; K = FF; N = D; kt = r / 16; nt = r % 16; woff = W_DN_OFF; }
        bf16_t* WT = (bf16_t*)(a.ws + WS_W + (size_t)l * W_LAYER + woff);
        const int n0 = nt * 64, k0 = kt * 64;
        int dn0 = n0;
        if (kind == 1) { dn0 = n0 < FF ? (n0 / 128) * 256 + (n0 % 128) : ((n0 - FF) / 128) * 256 + 128 + ((n0 - FF) % 128); }
#pragma unroll
        for (int p = 0; p < 2; ++p) { const int row = (tid >> 4) + 32 * p, c4 = tid & 15;
            const f32x4 v = *(const f32x4*)(W + (size_t)(k0 + row) * N + n0 + 4 * c4);
            tile[row * 65 + 4 * c4 + 0] = v[0]; tile[row * 65 + 4 * c4 + 1] = v[1]; tile[row * 65 + 4 * c4 + 2] = v[2]; tile[row * 65 + 4 * c4 + 3] = v[3]; }
        __syncthreads();
        { const int n = tid >> 3, kc = tid & 7; LAS const float* s = tile + (8 * kc) * 65 + n;
          u32x4 o; o.x = cvt_pk_bf16(s[0], s[65]); o.y = cvt_pk_bf16(s[2 * 65], s[3 * 65]); o.z = cvt_pk_bf16(s[4 * 65], s[5 * 65]); o.w = cvt_pk_bf16(s[6 * 65], s[7 * 65]);
          *(u32x4*)(WT + (size_t)(dn0 + n) * K + k0 + 8 * kc) = o; }
        __syncthreads();
    }
    if (MK_PRO_MASK & 4)
    { const float* ws_ = a.in[9]; bf16_t* wsb = (bf16_t*)(a.ws + WS_WSB);
      for (int i = bid * NTHREADS + tid; i < DEPTH * 4 * 128 * 128; i += G * NTHREADS) { const int s = i & 127, t = (i >> 7) & 127; const float v = (s <= t) ? ws_[i] : 0.f; wsb[i] = (bf16_t)(cvt_pk_bf16(v, 0.f) & 0xffffu); }
      const float* wp_ = a.in[6]; bf16_t* wpb = (bf16_t*)(a.ws + WS_WPB);
      for (int i = bid * NTHREADS + tid; i < DEPTH * 4 * 64 * 64; i += G * NTHREADS) { const int c = i & 63, e = (i >> 6) & 63, lg = i >> 12; wpb[i] = (bf16_t)(cvt_pk_bf16(wp_[(lg * 64 + c) * 64 + e], 0.f) & 0xffffu); } }
}

__device__ __forceinline__ void phase_pro2(const Args& a) {
    const int tid = opaque_tid(), lane = tid & 63, wave = tid >> 6, gw = opaque_bid() * 8 + wave, NGW = gridDim.x * 8;
    const int pair = gw & 7, l = pair >> 1, which = pair & 1, N = which ? GU : INW;
    const float* sh = (const float*)(a.ws + WS_MOD) + (size_t)l * 8 * NMOD + (which ? 3072 : 0);
    const bf16_t* WT = (const bf16_t*)(a.ws + WS_W + (size_t)l * W_LAYER + (which ? W_GU_OFF : W_IN_OFF));
    float* out = (float*)(a.ws + (which ? WS_SHW2 : WS_SHW1)) + (size_t)l * 8 * N;
    f32x4 sv[8][4];
#pragma unroll
    for (int b = 0; b < 8; ++b)
#pragma unroll
        for (int j = 0; j < 4; ++j) sv[b][j] = *(const f32x4*)(sh + (size_t)b * NMOD + 16 * lane + 4 * j);
    for (int n = gw >> 3; n < N; n += NGW >> 3) {
        const u32x4 w0 = *(const u32x4*)(WT + (size_t)n * D + 16 * lane), w1 = *(const u32x4*)(WT + (size_t)n * D + 16 * lane + 8);
        const f32x4 f0 = {bflo(w0.x), bfhi(w0.x), bflo(w0.y), bfhi(w0.y)}, f1 = {bflo(w0.z), bfhi(w0.z), bflo(w0.w), bfhi(w0.w)};
        const f32x4 f2 = {bflo(w1.x), bfhi(w1.x), bflo(w1.y), bfhi(w1.y)}, f3 = {bflo(w1.z), bfhi(w1.z), bflo(w1.w), bfhi(w1.w)};
        float r[8];
#pragma unroll
        for (int b = 0; b < 8; ++b) { const f32x4 p = sv[b][0] * f0 + sv[b][1] * f1 + sv[b][2] * f2 + sv[b][3] * f3; r[b] = wave_sum((p[0] + p[1]) + (p[2] + p[3])); }
        if (lane == 0) {
#pragma unroll
            for (int b = 0; b < 8; ++b) out[(size_t)b * N + n] = r[b]; }
    }
}
__device__ __forceinline__ void phase_gst(const Args& a) {
    const float* mod = (const float*)(a.ws + WS_MOD); float* gst = (float*)(a.ws + WS_GST);
    for (int i = opaque_bid() * NTHREADS + opaque_tid(); i < DEPTH * 2 * 8 * D; i += gridDim.x * NTHREADS) {
        const int k = i & 1023, b = (i >> 10) & 7, which = (i >> 13) & 1, l = i >> 14;
        gst[i] = a.in[which ? 13 : 4][l * D + k] * (1.0f + mod[(size_t)(l * 8 + b) * NMOD + (which ? 4096 : 1024) + k]); }
}
__device__ __forceinline__ void zero_rows(float* p) {
    for (int i = opaque_bid() * NTHREADS + opaque_tid(); i < M; i += gridDim.x * NTHREADS) p[i] = 0.f;
}

__device__ __forceinline__ void phase_norm(const float* xin, const float* g, const float* sh, const float* sc, bf16_t* hout, bf16_t* xbout) {
    const int tid = opaque_tid(), lane = tid & 63, wave = tid >> 6, gw = opaque_bid() * 8 + wave, NGW = gridDim.x * 8;
    const int b = gw & 7, r0 = gw >> 3, rstep = NGW >> 3;
    f32x4 gs[4], sv[4];
#pragma unroll
    for (int j = 0; j < 4; ++j) { const int col = 4 * lane + 256 * j; const f32x4 gg = *(const f32x4*)(g + col), ss = *(const f32x4*)(sc + (size_t)b * NMOD + col);
        gs[j] = gg * (ss + 1.0f); sv[j] = *(const f32x4*)(sh + (size_t)b * NMOD + col); }
    for (int r = r0; r < SEQ; r += rstep) {
        const size_t row = (size_t)b * SEQ + r; const f32x4* xr = (const f32x4*)(xin + row * D) + lane;
        f32x4 v[4]; float s = 0.f;
#pragma unroll
        for (int j = 0; j < 4; ++j) { v[j] = xr[64 * j]; s += (v[j][0] * v[j][0] + v[j][1] * v[j][1]) + (v[j][2] * v[j][2] + v[j][3] * v[j][3]); }
        const float rstd = __builtin_amdgcn_rsqf(wave_sum(s) * (1.0f / D) + EPS);
        u32x2* o = (u32x2*)(hout + row * D) + lane; u32x2* ox = (u32x2*)(xbout + row * D) + lane;
#pragma unroll
        for (int j = 0; j < 4; ++j) { const f32x4 y = v[j] * rstd * gs[j] + sv[j]; u32x2 w; w.x = cvt_pk_bf16(y[0], y[1]); w.y = cvt_pk_bf16(y[2], y[3]); o[64 * j] = w;
            u32x2 wx; wx.x = cvt_pk_bf16(v[j][0], v[j][1]); wx.y = cvt_pk_bf16(v[j][2], v[j][3]); ox[64 * j] = wx; }
    }
}
__device__ __forceinline__ void phase_final(const bf16_t* xb, const float* g, float* out) {
    const int tid = opaque_tid(), lane = tid & 63, wave = tid >> 6, gw = opaque_bid() * 8 + wave, NGW = gridDim.x * 8;
    f32x4 gs[4];
#pragma unroll
    for (int j = 0; j < 4; ++j) gs[j] = *(const f32x4*)(g + 4 * lane + 256 * j);
    for (int row = gw; row < M; row += NGW) {
        const u32x2* xr = (const u32x2*)(xb + (size_t)row * D) + lane; f32x4 v[4]; float s = 0.f;
#pragma unroll
        for (int j = 0; j < 4; ++j) { const u32x2 r = xr[64 * j]; v[j] = (f32x4){bflo(r.x), bfhi(r.x), bflo(r.y), bfhi(r.y)}; s += (v[j][0] * v[j][0] + v[j][1] * v[j][1]) + (v[j][2] * v[j][2] + v[j][3] * v[j][3]); }
        const float rstd = __builtin_amdgcn_rsqf(wave_sum(s) * (1.0f / D) + EPS);
        f32x4* o = (f32x4*)(out + (size_t)row * D) + lane;
#pragma unroll
        for (int j = 0; j < 4; ++j) o[64 * j] = v[j] * rstd * gs[j];
    }
}
__device__ __forceinline__ void attn_unit(int unit, const bf16_t* proj, bf16_t* merged, const float* mn, LAS unsigned char* lds, int wave, int lane) {
    const int b = unit >> 8, q0 = (unit & 255) * 32, n = lane & 31, h = lane >> 5, hd = wave;
    const size_t rowbase = (size_t)b * SEQ;
    constexpr float C1 = 0.125f * 1.4426950408889634f;
    bf16x8 bq[4];
    { const bf16_t* qp = proj + (rowbase + q0 + n) * INW + hd * 64 + 8 * h;
#pragma unroll
      for (int s = 0; s < 4; ++s) bq[s] = *(const bf16x8*)(qp + 16 * s); }
    f32x16 o0, o1;
#pragma unroll
    for (int i = 0; i < 16; ++i) { o0[i] = 0.f; o1[i] = 0.f; }
    float carry = 1.f;
    LAS unsigned char* kl = lds + wave * 9216; LAS unsigned char* vl = kl + 4608;
    const int nkt = min(17, (q0 >> 5) + 1);
    const int q4 = (lane & 15) >> 2, p4 = lane & 3, blk = (lane >> 4) & 1;
    u32x4 kv[4], vv[4];
    const bf16_t* kp = proj + (rowbase + q0) * INW + 512 + hd * 64 + (size_t)(lane >> 3) * INW + (lane & 7) * 8;
#pragma unroll
    for (int i = 0; i < 4; ++i) { kv[i] = *(const u32x4*)(kp + (size_t)(8 * i) * INW); vv[i] = *(const u32x4*)(kp + 512 + (size_t)(8 * i) * INW); }
    for (int kt = 0; kt < nkt; ++kt) {
#pragma unroll
        for (int i = 0; i < 4; ++i) { const int c = lane + 64 * i, row = c >> 3, ch = c & 7; *(LAS u32x4*)(kl + row * 144 + ch * 16) = kv[i]; *(LAS u32x4*)(vl + row * 144 + ch * 16) = vv[i]; }
        if (kt + 1 < nkt) { kp -= (size_t)32 * INW;
#pragma unroll
            for (int i = 0; i < 4; ++i) { kv[i] = *(const u32x4*)(kp + (size_t)(8 * i) * INW); vv[i] = *(const u32x4*)(kp + 512 + (size_t)(8 * i) * INW); } }
        asm volatile("s_waitcnt lgkmcnt(0)" ::: "memory");
        f32x16 st;
#pragma unroll
        for (int i = 0; i < 16; ++i) st[i] = 0.f;
#pragma unroll
        for (int s = 0; s < 4; ++s) { const bf16x8 ka = *(LAS const bf16x8*)(kl + n * 144 + (2 * s + h) * 16); st = MFMA32(ka, bq[s], st); }
        float be[16], om[16], w[16];
#pragma unroll
        for (int i = 0; i < 16; ++i) {
            const float e = __builtin_amdgcn_exp2f(fminf(st[i] * (-C1), 80.f));
            be[i] = __builtin_amdgcn_rcpf(1.0f + e);
            om[i] = e * be[i];
        }
        if (kt == 0 || kt == 16) {
#pragma unroll
            for (int i = 0; i < 16; ++i) { const bool valid = (kt == 0) ? (crow(i, h) < n) : (crow(i, h) >= n); be[i] = valid ? be[i] : 0.f; om[i] = valid ? om[i] : 1.f; }
        }
        const float G0 = (om[0] * om[1]) * (om[2] * om[3]), G1 = (om[4] * om[5]) * (om[6] * om[7]), G2 = (om[8] * om[9]) * (om[10] * om[11]), G3 = (om[12] * om[13]) * (om[14] * om[15]);
        const float P0 = __shfl_xor(G0, 32), P1 = __shfl_xor(G1, 32), P2 = __shfl_xor(G2, 32), P3 = __shfl_xor(G3, 32);
        const float S2 = G3 * P3, S1 = S2 * (G2 * P2), S0 = S1 * (G1 * P1), tot = S0 * (G0 * P0);
        float T[4]; T[0] = S0 * (h == 0 ? P0 : 1.f); T[1] = S1 * (h == 0 ? P1 : 1.f); T[2] = S2 * (h == 0 ? P2 : 1.f); T[3] = (h == 0 ? P3 : 1.f);
#pragma unroll
        for (int g = 0; g < 4; ++g) {
            float later = carry * T[g];
#pragma unroll
            for (int j = 3; j >= 0; --j) { const int i = 4 * g + j; w[i] = be[i] * later; later *= om[i]; }
        }
        carry *= tot;
        const bool done = __builtin_amdgcn_ballot_w64(carry >= 1e-20f) == 0ull;
        bf16x8 wf[2];
#pragma unroll
        for (int s = 0; s < 2; ++s) { u32x4 p; p.x = cvt_pk_bf16(w[8 * s], w[8 * s + 1]); p.y = cvt_pk_bf16(w[8 * s + 2], w[8 * s + 3]); p.z = cvt_pk_bf16(w[8 * s + 4], w[8 * s + 5]); p.w = cvt_pk_bf16(w[8 * s + 6], w[8 * s + 7]); wf[s] = __builtin_bit_cast(bf16x8, p); }
#pragma unroll
        for (int s = 0; s < 2; ++s) {
            LAS const unsigned char* vb = vl + (16 * s + 4 * h + q4) * 144 + 32 * blk + 8 * p4;
            const s16x4 lo0 = vtr(vb), hi0 = vtr(vb + 8 * 144), lo1 = vtr(vb + 64), hi1 = vtr(vb + 8 * 144 + 64);
            o0 = MFMA32(cat8(lo0, hi0), wf[s], o0);
            o1 = MFMA32(cat8(lo1, hi1), wf[s], o1);
        }
        asm volatile("" ::: "memory");
        if (done) break;
    }
    float ss = 0.f;
#pragma unroll
    for (int i = 0; i < 16; ++i) ss += o0[i] * o0[i] + o1[i] * o1[i];
    ss += __shfl_xor(ss, 32);
    LAS float* ex = (LAS float*)(lds + 73728 + (unit & 1) * 1024);
    if (h == 0) ex[wave * 32 + n] = ss;
    const float* mp = mn + hd * 64 + 4 * h;
    f32x4 mv0[4], mv1[4];
#pragma unroll
    for (int g = 0; g < 4; ++g) { mv0[g] = *(const f32x4*)(mp + 8 * g); mv1[g] = *(const f32x4*)(mp + 32 + 8 * g); }
    __syncthreads();
    float tot = 0.f;
#pragma unroll
    for (int w8 = 0; w8 < 8; ++w8) tot += ex[w8 * 32 + n];
    const float rstd = __builtin_amdgcn_rsqf(tot * (1.0f / 512.0f) + EPS);
    bf16_t* op = merged + (rowbase + q0 + n) * D + hd * 64 + 4 * h;
#pragma unroll
    for (int g = 0; g < 4; ++g) {
        const f32x4 m0 = mv0[g], m1 = mv1[g];
        u32x2 a0, a1;
        a0.x = cvt_pk_bf16(o0[4 * g] * rstd * m0[0], o0[4 * g + 1] * rstd * m0[1]); a0.y = cvt_pk_bf16(o0[4 * g + 2] * rstd * m0[2], o0[4 * g + 3] * rstd * m0[3]);
        a1.x = cvt_pk_bf16(o1[4 * g] * rstd * m1[0], o1[4 * g + 1] * rstd * m1[1]); a1.y = cvt_pk_bf16(o1[4 * g + 2] * rstd * m1[2], o1[4 * g + 3] * rstd * m1[3]);
        *(u32x2*)(op + 8 * g) = a0; *(u32x2*)(op + 32 + 8 * g) = a1;
    }
}

__device__ __forceinline__ void sg_unit(int unit, const bf16_t* proj, bf16_t* merged, const float* mn, const float* sgn, const bf16_t* wsb, const float* bs, LAS unsigned char* lds, int tid, int wave, int lane) {
    const size_t R0 = (size_t)unit * 128;
    constexpr int RS = 528;
    { const int t = tid >> 2, part = tid & 3;
      const bf16_t* vp = proj + (R0 + t) * INW + 2048 + 64 * part;
      u32x4 raw[8];
#pragma unroll
      for (int i = 0; i < 8; ++i) raw[i] = *(const u32x4*)(vp + 8 * i);
      float s = 0.f;
#pragma unroll
      for (int i = 0; i < 8; ++i) s += (bflo(raw[i].x) + bfhi(raw[i].x)) + (bflo(raw[i].y) + bfhi(raw[i].y)) + (bflo(raw[i].z) + bfhi(raw[i].z)) + (bflo(raw[i].w) + bfhi(raw[i].w));
      s += __shfl_xor(s, 1); s += __shfl_xor(s, 2);
      const float mean = s * (1.0f / 256.0f);
      float q = 0.f;
#pragma unroll
      for (int i = 0; i < 8; ++i) { float d;
          d = bflo(raw[i].x) - mean; q += d * d; d = bfhi(raw[i].x) - mean; q += d * d; d = bflo(raw[i].y) - mean; q += d * d; d = bfhi(raw[i].y) - mean; q += d * d;
          d = bflo(raw[i].z) - mean; q += d * d; d = bfhi(raw[i].z) - mean; q += d * d; d = bflo(raw[i].w) - mean; q += d * d; d = bfhi(raw[i].w) - mean; q += d * d; }
      q += __shfl_xor(q, 1); q += __shfl_xor(q, 2);
      const float rstd = __builtin_amdgcn_rsqf(q * (1.0f / 256.0f) + EPS);
      const float* gp = sgn + 64 * part;
#pragma unroll
      for (int i = 0; i < 8; ++i) { const f32x4 ga = *(const f32x4*)(gp + 8 * i), gb = *(const f32x4*)(gp + 8 * i + 4); u32x4 o;
          o.x = cvt_pk_bf16((bflo(raw[i].x) - mean) * rstd * ga[0], (bfhi(raw[i].x) - mean) * rstd * ga[1]); o.y = cvt_pk_bf16((bflo(raw[i].y) - mean) * rstd * ga[2], (bfhi(raw[i].y) - mean) * rstd * ga[3]);
          o.z = cvt_pk_bf16((bflo(raw[i].z) - mean) * rstd * gb[0], (bfhi(raw[i].z) - mean) * rstd * gb[1]); o.w = cvt_pk_bf16((bflo(raw[i].w) - mean) * rstd * gb[2], (bfhi(raw[i].w) - mean) * rstd * gb[3]);
          *(LAS u32x4*)(lds + t * RS + 2 * (64 * part + 8 * i)) = o; }
    }
    __syncthreads();
    const int h4 = wave >> 1, dh = wave & 1, n = lane & 31, h = lane >> 5, cbase = 64 * h4 + 32 * dh;
    const int q4 = (lane & 15) >> 2, p4 = lane & 3, blk = (lane >> 4) & 1;
    f32x16 acc[4];
#pragma unroll
    for (int tt = 0; tt < 4; ++tt)
#pragma unroll
        for (int i = 0; i < 16; ++i) acc[tt][i] = 0.f;
#pragma unroll
    for (int ks = 0; ks < 8; ++ks) {
        LAS const unsigned char* vb = lds + (16 * ks + 8 * h + q4) * RS + 2 * (cbase + 16 * blk) + 8 * p4;
        const bf16x8 af = cat8(vtr(vb), vtr(vb + 4 * RS));
#pragma unroll
        for (int tt = 0; tt < 4; ++tt) if (ks < 2 * (tt + 1)) {
            const bf16x8 bfr = *(const bf16x8*)(wsb + (size_t)(h4 * 128 + 32 * tt + n) * 128 + 16 * ks + 8 * h);
            acc[tt] = MFMA32(af, bfr, acc[tt]); }
    }
    LAS float* ex = (LAS float*)(lds + 67584);
#pragma unroll
    for (int tt = 0; tt < 4; ++tt) { const int t = 32 * tt + n; const float bias = bs[h4 * 128 + t]; const bf16_t* up = proj + (R0 + t) * INW + 1792 + cbase + 4 * h; float s = 0.f;
#pragma unroll
        for (int g = 0; g < 4; ++g) { const u32x2 uu = *(const u32x2*)(up + 8 * g);
            const float v0 = bflo(uu.x) * (acc[tt][4 * g] + bias), v1 = bfhi(uu.x) * (acc[tt][4 * g + 1] + bias), v2 = bflo(uu.y) * (acc[tt][4 * g + 2] + bias), v3 = bfhi(uu.y) * (acc[tt][4 * g + 3] + bias);
            acc[tt][4 * g] = v0; acc[tt][4 * g + 1] = v1; acc[tt][4 * g + 2] = v2; acc[tt][4 * g + 3] = v3; s += (v0 * v0 + v1 * v1) + (v2 * v2 + v3 * v3); }
        s += __shfl_xor(s, 32);
        if (h == 0) ex[wave * 128 + t] = s; }
    __syncthreads();
#pragma unroll
    for (int tt = 0; tt < 4; ++tt) { const int t = 32 * tt + n; float tot = 0.f;
#pragma unroll
        for (int w8 = 0; w8 < 8; ++w8) tot += ex[w8 * 128 + t];
        const float rstd = __builtin_amdgcn_rsqf(tot * (1.0f / 256.0f) + EPS);
        bf16_t* op = merged + (R0 + t) * D + 768 + cbase + 4 * h; const float* mp = mn + 768 + cbase + 4 * h;
#pragma unroll
        for (int g = 0; g < 4; ++g) { const f32x4 m0 = *(const f32x4*)(mp + 8 * g); u32x2 a0;
            a0.x = cvt_pk_bf16(acc[tt][4 * g] * rstd * m0[0], acc[tt][4 * g + 1] * rstd * m0[1]); a0.y = cvt_pk_bf16(acc[tt][4 * g + 2] * rstd * m0[2], acc[tt][4 * g + 3] * rstd * m0[3]);
            *(u32x2*)(op + 8 * g) = a0; } }
    __syncthreads();
}

__device__ __forceinline__ void pool_unit(int unit, const bf16_t* proj, bf16_t* merged, const float* mn, const bf16_t* wpb, const float* pscale, LAS unsigned char* lds, int tid, int wave, int lane) {
    const size_t T0 = (size_t)unit * 128; const int pos0 = (unit & 63) * 128;
    constexpr int RS = 528;
    for (int c = tid; c < 144 * 32; c += NTHREADS) { const int li = c >> 5, ch = c & 31; u32x4 v = (u32x4){0u, 0u, 0u, 0u};
        if (li >= 16 || pos0 > 0) v = *(const u32x4*)(proj + (T0 + li - 16) * INW + 1536 + 8 * ch);
        *(LAS u32x4*)(lds + li * RS + 16 * ch) = v; }
    __syncthreads();
    const int g = wave >> 1, ttp = wave & 1, n = lane & 31, h = lane >> 5, W = 2 << g;
    f32x16 acc[2][2];
#pragma unroll
    for (int a = 0; a < 2; ++a)
#pragma unroll
        for (int e2 = 0; e2 < 2; ++e2)
#pragma unroll
            for (int i = 0; i < 16; ++i) acc[a][e2][i] = 0.f;
    bf16x8 af[2][4];
#pragma unroll
    for (int e2 = 0; e2 < 2; ++e2)
#pragma unroll
        for (int ks = 0; ks < 4; ++ks) af[e2][ks] = *(const bf16x8*)(wpb + (size_t)(g * 64 + 32 * e2 + n) * 64 + 16 * ks + 8 * h);
#pragma unroll
    for (int a = 0; a < 2; ++a) {
        const int tt = 2 * ttp + a, li = 16 + 32 * tt + n, pos = pos0 + 32 * tt + n; const float inv = 1.0f / (float)min(pos + 1, W);
#pragma unroll
        for (int ks = 0; ks < 4; ++ks) {
            LAS const unsigned char* pb = lds + li * RS + 2 * (64 * g + 16 * ks + 8 * h);
            float sm[8];
#pragma unroll
            for (int k = 0; k < 8; ++k) sm[k] = 0.f;
            for (int j = 0; j < W; ++j) { const u32x4 v = *(LAS const u32x4*)(pb - j * RS);
                sm[0] += bflo(v.x); sm[1] += bfhi(v.x); sm[2] += bflo(v.y); sm[3] += bfhi(v.y); sm[4] += bflo(v.z); sm[5] += bfhi(v.z); sm[6] += bflo(v.w); sm[7] += bfhi(v.w); }
            const u32x4 own = *(LAS const u32x4*)pb; u32x4 p;
            p.x = cvt_pk_bf16(sm[0] * inv - bflo(own.x), sm[1] * inv - bfhi(own.x)); p.y = cvt_pk_bf16(sm[2] * inv - bflo(own.y), sm[3] * inv - bfhi(own.y));
            p.z = cvt_pk_bf16(sm[4] * inv - bflo(own.z), sm[5] * inv - bfhi(own.z)); p.w = cvt_pk_bf16(sm[6] * inv - bflo(own.w), sm[7] * inv - bfhi(own.w));
            const bf16x8 pf = __builtin_bit_cast(bf16x8, p);
            acc[a][0] = MFMA32(af[0][ks], pf, acc[a][0]);
            acc[a][1] = MFMA32(af[1][ks], pf, acc[a][1]);
        }
    }
    LAS float* ex = (LAS float*)(lds + 76032);
#pragma unroll
    for (int a = 0; a < 2; ++a) { float s = 0.f;
#pragma unroll
        for (int e2 = 0; e2 < 2; ++e2)
#pragma unroll
            for (int gg = 0; gg < 4; ++gg) { const f32x4 ps = *(const f32x4*)(pscale + 64 * g + 32 * e2 + 4 * h + 8 * gg);
#pragma unroll
                for (int j = 0; j < 4; ++j) { const float v = acc[a][e2][4 * gg + j] * ps[j]; acc[a][e2][4 * gg + j] = v; s += v * v; } }
        s += __shfl_xor(s, 32);
        if (h == 0) ex[g * 128 + 32 * (2 * ttp + a) + n] = s; }
    __syncthreads();
#pragma unroll
    for (int a = 0; a < 2; ++a) { const int t = 32 * (2 * ttp + a) + n;
        const float tot = (ex[t] + ex[128 + t]) + (ex[256 + t] + ex[384 + t]);
        const float rstd = __builtin_amdgcn_rsqf(tot * (1.0f / 256.0f) + EPS);
#pragma unroll
        for (int e2 = 0; e2 < 2; ++e2) { const int ebase = 64 * g + 32 * e2 + 4 * h;
            bf16_t* op = merged + (T0 + t) * D + 512 + ebase; const float* mp = mn + 512 + ebase;
#pragma unroll
            for (int gg = 0; gg < 4; ++gg) { const f32x4 m0 = *(const f32x4*)(mp + 8 * gg); u32x2 a0;
                a0.x = cvt_pk_bf16(acc[a][e2][4 * gg] * rstd * m0[0], acc[a][e2][4 * gg + 1] * rstd * m0[1]); a0.y = cvt_pk_bf16(acc[a][e2][4 * gg + 2] * rstd * m0[2], acc[a][e2][4 * gg + 3] * rstd * m0[3]);
                *(u32x2*)(op + 8 * gg) = a0; } } }
    __syncthreads();
}

__device__ __forceinline__ void phase_mix(const Args& a, int l, LAS unsigned char* lds) {
    const int tid = opaque_tid(), lane = tid & 63, wave = __builtin_amdgcn_readfirstlane(tid >> 6), G = gridDim.x, bid = opaque_bid();
    const bf16_t* proj = (const bf16_t*)(a.ws + WS_P); bf16_t* merged = (bf16_t*)(a.ws + WS_H);
    const float* mn = a.in[11] + (size_t)l * D;
    { const int per = (M / 32 + G - 1) / G;
      for (int u = bid * per; u < min(M / 32, (bid + 1) * per); ++u) attn_unit(u, proj, merged, mn, lds, wave, lane); }
    __syncthreads();
    { const float* sgn = a.in[8] + l * 256; const bf16_t* wsb = (const bf16_t*)(a.ws + WS_WSB) + (size_t)l * 4 * 128 * 128; const float* bs = a.in[10] + l * 4 * 128;
      for (int u = bid; u < M / 128; u += G) sg_unit(u, proj, merged, mn, sgn, wsb, bs, lds, tid, wave, lane); }
    { const bf16_t* wpb = (const bf16_t*)(a.ws + WS_WPB) + (size_t)l * 4 * 64 * 64; const float* pscale = a.in[7] + l * 256;
      for (int u = bid; u < M / 128; u += G) pool_unit(u, proj, merged, mn, wpb, pscale, lds, tid, wave, lane); }
}
constexpr int N_STEPS = 3 + 5 * DEPTH;
__global__ void __launch_bounds__(NTHREADS, 2) fwd(Args args) {
    extern __shared__ __attribute__((aligned(16))) unsigned char lds_raw[];
    LAS unsigned char* lds = (LAS unsigned char*)lds_raw;
#if MK_ONE_LAUNCH
#define SEAM() grid_bar(bar_ctr, bar_target)
#define SEAM_CG() do { __syncthreads(); cg::this_grid().sync(); } while (0)
#else
#define SEAM() do { } while (0)
#define SEAM_CG() do { } while (0)
#endif
#define RUN(k) (args.ph_lo <= (k) && (k) < args.ph_hi && (k) < MK_MAX_STEP)
    unsigned char* ws = args.ws;
    const float* mod = (const float*)(ws + WS_MOD);
    bf16_t* hbuf = (bf16_t*)(ws + WS_H); bf16_t* pbuf = (bf16_t*)(ws + WS_P);
    unsigned* bar_ctr = (unsigned*)(ws + WS_BAR); unsigned bar_target = 0u; (void)bar_ctr; (void)bar_target;
    if (RUN(0)) phase_pro(args, lds);
    SEAM_CG();
    bf16_t* xbres = (bf16_t*)(ws + WS_XB); bf16_t* xs2 = (bf16_t*)(ws + WS_XS2); float* rsqA = (float*)(ws + WS_RSQA); float* rsqB = (float*)(ws + WS_RSQB);
    if (RUN(1)) { phase_pro2(args); phase_gst(args); phase_norm(args.in[0], args.in[4], mod, mod + 1024, hbuf, xbres); }
    SEAM();
#pragma nounroll
    for (int l = 0; l < DEPTH; ++l) {
        const int s0 = 2 + 5 * l;
        const float* modl = mod + (size_t)l * 8 * NMOD;
        const unsigned char* wl = ws + WS_W + (size_t)l * W_LAYER;
        if (RUN(s0 + 0)) {
            pg8::Gemm g{hbuf, (const bf16_t*)(wl + W_IN_OFF), M, INW, D}; pg8::StaticOrder S; S.init(M, INW, gridDim.x, opaque_bid(), l > 0 ? 1 : 0);
            pg8::EpiProj E{pbuf, l == 0 ? nullptr : rsqB, (const float*)(ws + WS_SHW1) + (size_t)l * 8 * INW};
            pg8::gemm_phase<pg8::EpiProj, pg8::StaticOrder, true, true>(lds, g, S, E); }
        SEAM();
        if (RUN(s0 + 1)) phase_mix(args, l, lds);
        SEAM();
        if (RUN(s0 + 2)) { pg8::Gemm g{hbuf, (const bf16_t*)(wl + W_OUT_OFF), M, D, D}; pg8::StaticOrder S; S.init(M, D, gridDim.x, opaque_bid());
            pg8::EpiRes E{xbres, modl + 2048, xs2, rsqA, (const float*)(ws + WS_GST) + (size_t)(l * 2 + 1) * 8 * D, (LAS float*)(lds + 131072)};
            pg8::gemm_phase<pg8::EpiRes, pg8::StaticOrder, true, true>(lds, g, S, E); }
        SEAM();
        if (RUN(s0 + 3)) {
            pg8::Gemm g{xs2, (const bf16_t*)(wl + W_GU_OFF), M, GU, D}; pg8::StaticOrder S; S.init(M, GU, gridDim.x, opaque_bid(), 1);
            pg8::EpiSwiglu E{pbuf, rsqA, (const float*)(ws + WS_SHW2) + (size_t)l * 8 * GU};
            pg8::gemm_phase<pg8::EpiSwiglu, pg8::StaticOrder, true, true>(lds, g, S, E); }
        SEAM();
        if (RUN(s0 + 4)) { const bool last = (l == DEPTH - 1); const int ln = last ? l : l + 1;
            pg8::Gemm g{pbuf, (const bf16_t*)(wl + W_DN_OFF), M, D, FF}; pg8::StaticOrder S; S.init(M, D, gridDim.x, opaque_bid(), 0);
            pg8::EpiRes E{xbres, modl + 5120, last ? nullptr : hbuf, rsqB, (const float*)(ws + WS_GST) + (size_t)(ln * 2) * 8 * D, (LAS float*)(lds + 131072)};
            pg8::gemm_phase<pg8::EpiRes, pg8::StaticOrder, true, true>(lds, g, S, E); }
        SEAM();
    }
    if (RUN(N_STEPS - 1)) phase_final(xbres, args.in[16], args.out);
#undef RUN
#undef SEAM
#undef SEAM_CG
}

extern "C" void kernel_launch(void* const* d_in, const int* in_sizes, int n_in, void* d_out, int out_size, void* d_ws, size_t ws_size, hipStream_t stream) {
    static int grid = 0;
    if (grid == 0) {
        if (n_in != 17 || in_sizes[0] != M * D || out_size != M * D || ws_size < WS_END2) { fprintf(stderr, "kernel_launch: unexpected shapes (n_in %d in0 %d out %d ws %zu)\n", n_in, n_in > 0 ? in_sizes[0] : -1, out_size, ws_size); grid = -1; return; }
        int dev = 0, cus = 0, per_cu = 0;
        if (hipGetDevice(&dev) != hipSuccess || hipDeviceGetAttribute(&cus, hipDeviceAttributeMultiprocessorCount, dev) != hipSuccess) { grid = -1; return; }
        if (hipFuncSetAttribute((const void*)fwd, hipFuncAttributeMaxDynamicSharedMemorySize, LDS_BYTES) != hipSuccess) { fprintf(stderr, "kernel_launch: hipFuncSetAttribute failed\n"); grid = -1; return; }
        if (hipOccupancyMaxActiveBlocksPerMultiprocessor(&per_cu, (const void*)fwd, NTHREADS, LDS_BYTES) != hipSuccess || per_cu < 1) { fprintf(stderr, "kernel_launch: occupancy query gave %d\n", per_cu); per_cu = 1; }
        (void)hipGetLastError();
        grid = cus * per_cu;
    }
    if (grid < 0) return;
    Args a{};
    for (int i = 0; i < 17; ++i) a.in[i] = (const float*)d_in[i];
    a.out = (float*)d_out; a.ws = (unsigned char*)d_ws;
#if MK_ONE_LAUNCH
    if (hipMemsetAsync((char*)d_ws + WS_BAR, 0, 256, stream) != hipSuccess) { fprintf(stderr, "kernel_launch: memset failed\n"); return; }
    a.ph_lo = 0; a.ph_hi = N_STEPS;
    void* params[] = {&a};
    hipError_t e = hipLaunchCooperativeKernel((const void*)fwd, dim3(grid), dim3(NTHREADS), params, LDS_BYTES, stream);
    if (e != hipSuccess) fprintf(stderr, "cooperative launch failed: %s (grid %d)\n", hipGetErrorString(e), grid);
#else
    for (int k = 0; k < N_STEPS && k < (MK_MAX_STEP > 0 ? MK_MAX_STEP : 1); ++k) { a.ph_lo = k; a.ph_hi = k + 1; hipLaunchKernelGGL(fwd, dim3(grid), dim3(NTHREADS), LDS_BYTES, stream, a); }
#endif
}
```
